# Optimizing an MI355X kernel written in HIP

```python
import jax, jax.numpy as jnp
from jax import lax
import numpy as np

D_MODEL = 2048
BATCH = 2
SEQ = 4096
DEPTH = 1

FOX_HEADS = 8
FOX_HEAD_DIM = 128
FOX_WIDTH = FOX_HEADS * FOX_HEAD_DIM
SWA_Q_HEADS = 16
SWA_KV_HEADS = 2
SWA_HEAD_DIM = 64
SWA_WIDTH = SWA_Q_HEADS * SWA_HEAD_DIM
SWA_KV_WIDTH = SWA_KV_HEADS * SWA_HEAD_DIM
WINDOW = 128
Q_BLOCK = 128
ROPE_THETA = 10000.0
PLE_DIM = 256
NORM_EPS = 1e-6

SPLIT_SIZES = (
    FOX_WIDTH,
    FOX_WIDTH,
    FOX_WIDTH,
    FOX_WIDTH,
    FOX_HEADS,
    SWA_WIDTH,
    SWA_KV_WIDTH,
    SWA_KV_WIDTH,
    SWA_WIDTH,
    D_MODEL,
    D_MODEL,
)
N_IN = sum(SPLIT_SIZES)

kernel_name = "fox_swa_sink_gated_hybrid"


def rms_norm(x, g):
    xf = x.astype(jnp.float32)
    y = xf * lax.rsqrt(jnp.mean(xf * xf, axis=-1, keepdims=True) + NORM_EPS)
    return (y * g.astype(jnp.float32)).astype(x.dtype)


def apply_rope(x, pos):
    half = x.shape[-1] // 2
    inv = ROPE_THETA ** (-jnp.arange(half, dtype=jnp.float32) / half)
    ang = pos.astype(jnp.float32)[..., None] * inv
    cos = jnp.cos(ang)[:, :, None, :]
    sin = jnp.sin(ang)[:, :, None, :]
    xf = x.astype(jnp.float32)
    x1, x2 = xf[..., :half], xf[..., half:]
    out = jnp.concatenate([x1 * cos - x2 * sin, x2 * cos + x1 * sin], axis=-1)
    return out.astype(x.dtype)


def forgetting_attention(q, k, v, log_f):
    B, S, H, D = q.shape
    nb = S // Q_BLOCK
    c = jnp.cumsum(log_f.astype(jnp.float32), axis=1)
    cT = c.transpose(0, 2, 1)
    qb = q.reshape(B, nb, Q_BLOCK, H, D).transpose(1, 0, 2, 3, 4)
    cb = cT.reshape(B, H, nb, Q_BLOCK).transpose(2, 0, 1, 3)
    kpos = jnp.arange(S)
    scale = D ** -0.5

    def one_block(args):
        i, q_i, c_i = args
        s = jnp.einsum('bqhd,bkhd->bhqk', q_i, k, preferred_element_type=jnp.float32) * scale
        s = s + c_i[..., :, None] - cT[..., None, :]
        qpos = i * Q_BLOCK + jnp.arange(Q_BLOCK)
        causal = kpos[None, :] <= qpos[:, None]
        s = jnp.where(causal, s, -jnp.inf)
        w = jax.nn.softmax(s, axis=-1)
        return jnp.einsum('bhqk,bkhd->bqhd', w.astype(v.dtype), v)

    out = lax.map(one_block, (jnp.arange(nb), qb, cb))
    return out.transpose(1, 0, 2, 3, 4).reshape(B, S, H, D)


def sliding_window_sink_attention(q, k, v, sinks):
    B, S, Hq, D = q.shape
    Hkv = k.shape[2]
    G = Hq // Hkv
    nb = S // WINDOW
    qb = q.reshape(B, nb, WINDOW, Hkv, G, D)
    kb = k.reshape(B, nb, WINDOW, Hkv, D)
    vb = v.reshape(B, nb, WINDOW, Hkv, D)
    pad = ((0, 0), (1, 0), (0, 0), (0, 0), (0, 0))
    kk = jnp.concatenate([jnp.pad(kb, pad)[:, :-1], kb], axis=2)
    vv = jnp.concatenate([jnp.pad(vb, pad)[:, :-1], vb], axis=2)
    s = jnp.einsum('bnqhgd,bnkhd->bnhgqk', qb, kk,
                   preferred_element_type=jnp.float32) * (D ** -0.5)
    qi = jnp.arange(WINDOW)[:, None] + WINDOW
    ki = jnp.arange(2 * WINDOW)[None, :]
    rel = qi - ki
    band = (rel >= 0) & (rel < WINDOW)
    has_prev = (jnp.arange(nb) > 0)[:, None, None] | (ki >= WINDOW)[None]
    mask = band[None] & has_prev
    s = jnp.where(mask[None, :, None, None], s, -jnp.inf)
    sink = sinks.astype(jnp.float32).reshape(Hkv, G)[None, None, :, :, None, None]
    m = jnp.maximum(jnp.max(s, axis=-1, keepdims=True), sink)
    e = jnp.exp(s - m)
    w = e / (jnp.sum(e, axis=-1, keepdims=True) + jnp.exp(sink - m))
    out = jnp.einsum('bnhgqk,bnkhd->bnqhgd', w.astype(v.dtype), vv)
    return out.reshape(B, S, Hq, D)


def setup_inputs(seed: int = 0) -> dict:
    key = jax.random.key(seed)
    ks = jax.random.split(key, 16)
    f32 = jnp.float32
    x = jax.random.normal(ks[0], (BATCH, SEQ, D_MODEL), f32)
    p = jax.random.normal(ks[1], (DEPTH, BATCH, SEQ, PLE_DIM), f32)
    offset = jax.random.randint(ks[2], (BATCH, 1), 0, 1024, dtype=jnp.int32)
    positions = (offset + jnp.arange(SEQ, dtype=jnp.int32)[None, :]).astype(jnp.int32)
    pre_norm_g = 1.0 + 0.05 * jax.random.normal(ks[3], (DEPTH, D_MODEL), f32)
    w_in = jax.random.normal(ks[4], (DEPTH, D_MODEL, N_IN), f32) * D_MODEL ** -0.5
    b_forget = jax.random.uniform(ks[5], (DEPTH, FOX_HEADS), f32, 1.0, 4.0)
    sinks = 0.5 * jax.random.normal(ks[6], (DEPTH, SWA_Q_HEADS), f32)
    w_o_fox = jax.random.normal(ks[7], (DEPTH, FOX_WIDTH, D_MODEL), f32) * FOX_WIDTH ** -0.5
    w_o_swa = jax.random.normal(ks[8], (DEPTH, SWA_WIDTH, D_MODEL), f32) * SWA_WIDTH ** -0.5
    w_out = jax.random.normal(ks[9], (DEPTH, D_MODEL, D_MODEL), f32) * D_MODEL ** -0.5
    post_norm_g = 1.0 + 0.05 * jax.random.normal(ks[10], (DEPTH, D_MODEL), f32)
    w_ple = jax.random.normal(ks[11], (DEPTH, PLE_DIM, D_MODEL), f32) * PLE_DIM ** -0.5
    w_ple_gate = jax.random.normal(ks[12], (DEPTH, D_MODEL, D_MODEL), f32) * D_MODEL ** -0.5
    return {"x": x, "p": p, "positions": positions, "pre_norm_g": pre_norm_g, "w_in": w_in,
            "b_forget": b_forget, "sinks": sinks, "w_o_fox": w_o_fox, "w_o_swa": w_o_swa,
            "w_out": w_out, "post_norm_g": post_norm_g, "w_ple": w_ple, "w_ple_gate": w_ple_gate}


def reference(x, p, positions, pre_norm_g, w_in, b_forget, sinks, w_o_fox, w_o_swa,
              w_out, post_norm_g, w_ple, w_ple_gate):
    B, S, _ = x.shape
    cuts = np.cumsum(SPLIT_SIZES)[:-1].tolist()
    for i in range(DEPTH):
        h = rms_norm(x, pre_norm_g[i])
        proj = jnp.einsum('bsd,dn->bsn', h, w_in[i])
        (q_a, k_a, v_a, z_a, f_a, q_b, k_b, v_b, z_b, g_a, g_b) = jnp.split(proj, cuts, axis=-1)

        log_f = jax.nn.log_sigmoid(f_a.astype(jnp.float32) + b_forget[i].astype(jnp.float32))
        y_a = forgetting_attention(q_a.reshape(B, S, FOX_HEADS, FOX_HEAD_DIM),
                                   k_a.reshape(B, S, FOX_HEADS, FOX_HEAD_DIM),
                                   v_a.reshape(B, S, FOX_HEADS, FOX_HEAD_DIM), log_f)
        y_a = y_a.reshape(B, S, FOX_WIDTH) * jax.nn.silu(z_a)
        y_a = jnp.einsum('bsc,cd->bsd', y_a, w_o_fox[i])

        qr = apply_rope(q_b.reshape(B, S, SWA_Q_HEADS, SWA_HEAD_DIM), positions)
        kr = apply_rope(k_b.reshape(B, S, SWA_KV_HEADS, SWA_HEAD_DIM), positions)
        y_b = sliding_window_sink_attention(qr, kr, v_b.reshape(B, S, SWA_KV_HEADS, SWA_HEAD_DIM),
                                            sinks[i])
        y_b = y_b.reshape(B, S, SWA_WIDTH) * jax.nn.silu(z_b)
        y_b = jnp.einsum('bsc,cd->bsd', y_b, w_o_swa[i])

        merged = jax.nn.sigmoid(g_a) * y_a + jax.nn.sigmoid(g_b) * y_b
        out = jnp.einsum('bsd,de->bse', merged, w_out[i])
        x = x + rms_norm(out, post_norm_g[i])

        e = jnp.einsum('bsp,pd->bsd', p[i].astype(x.dtype), w_ple[i])
        gate = jax.nn.sigmoid(jnp.einsum('bsd,de->bse', x, w_ple_gate[i]))
        x = x + gate * e
    return x
```

```cpp
#include <hip/hip_runtime.h>
#include <cstdio>
#include <cstdint>

constexpr int BATCH = 2, SEQ = 4096, T = BATCH * SEQ, DM = 2048, NIN = 10504;
constexpr int FH = 8, FD = 128, FW = 1024;
constexpr int SQH = 16, SKH = 2, SD = 64, SW = 1024, SKW = 128, WIN = 128;
constexpr int PLE = 256;
constexpr float EPS = 1e-6f;
constexpr int C_QA = 0, C_KA = 1024, C_VA = 2048, C_ZA = 3072, C_F = 4096, C_QB = 4104, C_KB = 5128, C_VB = 5256, C_ZB = 5384, C_GA = 6408, C_GB = 8456;

typedef unsigned short bf16_t;
typedef float f32x4 __attribute__((ext_vector_type(4)));
typedef unsigned u32x4 __attribute__((ext_vector_type(4)));
typedef unsigned u32x2 __attribute__((ext_vector_type(2)));

__device__ __forceinline__ float bf2f(bf16_t v) { return __uint_as_float(((unsigned)v) << 16); }
__device__ __forceinline__ unsigned f2bf(float f) { unsigned u = __float_as_uint(f); return (u + 0x7fffu + ((u >> 16) & 1u)) >> 16; }
__device__ __forceinline__ unsigned pk2(float lo, float hi) { return f2bf(lo) | (f2bf(hi) << 16); }
__device__ __forceinline__ float sigmoidf_(float x) { return 1.0f / (1.0f + __expf(-x)); }

constexpr size_t MiB = 1u << 20;
constexpr size_t WS_CTL = 0;
constexpr size_t WS_CS = 1 * MiB;
constexpr size_t WS_LF = 1 * MiB + 512 * 1024;
constexpr size_t WS_COS = 2 * MiB, WS_SIN = 3 * MiB;
constexpr size_t WS_WOF = 4 * MiB, WS_WOS = 8 * MiB, WS_WOUT = 12 * MiB, WS_WG = 20 * MiB, WS_WPLE = 28 * MiB;
constexpr size_t WS_PB = 29 * MiB;
constexpr size_t WS_WIN = 33 * MiB;
constexpr size_t WS_YA = 33 * MiB, WS_YB = 49 * MiB;
constexpr size_t WS_XN = 74 * MiB;
constexpr size_t WS_QA = 106 * MiB, WS_KA = 122 * MiB, WS_VA = 138 * MiB, WS_ZA = 154 * MiB;
constexpr size_t WS_OUTP = 106 * MiB;
constexpr size_t WS_QB = 170 * MiB, WS_KB = 186 * MiB, WS_VB = 188 * MiB, WS_ZB = 190 * MiB;
constexpr size_t WS_GA = 206 * MiB, WS_GB = 238 * MiB, WS_E = 270 * MiB, WS_END = 302 * MiB;

__constant__ double INVF_REV[32] = {0.15915494309189535,0.11934937021124886,0.08949940160889101,0.06711508300522726,0.050329212104487035,0.03774158471741977,0.0283021958306234,0.02122365276477766,0.015915494309189534,0.011934937021124886,0.008949940160889102,0.006711508300522725,0.005032921210448704,0.003774158471741977,0.00283021958306234,0.0021223652764777662,0.0015915494309189536,0.0011934937021124885,0.0008949940160889102,0.0006711508300522726,0.0005032921210448703,0.00037741584717419774,0.00028302195830623395,0.0002122365276477766,0.00015915494309189535,0.00011934937021124886,8.949940160889102e-05,6.711508300522725e-05,5.0329212104487035e-05,3.774158471741978e-05,2.8302195830623396e-05,2.122365276477766e-05};

__device__ __forceinline__ float wave_sum(float v) {
#pragma unroll
    for (int o = 1; o < 64; o <<= 1) v += __shfl_xor(v, o);
    return v;
}
__device__ __forceinline__ float wave_max(float v) {
#pragma unroll
    for (int o = 1; o < 64; o <<= 1) v = fmaxf(v, __shfl_xor(v, o));
    return v;
}
__device__ __forceinline__ void sincos_rev(double rev, float& c, float& s) {
    const int k = (int)(rev * 4.0 + 0.5);
    const double th = (rev - 0.25 * (double)k) * 6.283185307179586476925;
    const double t2 = th * th;
    double sp = -1.0 / 1307674368000.0;
    sp = sp * t2 + 1.0 / 6227020800.0; sp = sp * t2 - 1.0 / 39916800.0; sp = sp * t2 + 1.0 / 362880.0; sp = sp * t2 - 1.0 / 5040.0; sp = sp * t2 + 1.0 / 120.0; sp = sp * t2 - 1.0 / 6.0; sp = sp * t2 + 1.0;
    const double sn = sp * th;
    double cp = 1.0 / 20922789888000.0;
    cp = cp * t2 - 1.0 / 87178291200.0; cp = cp * t2 + 1.0 / 479001600.0; cp = cp * t2 - 1.0 / 3628800.0; cp = cp * t2 + 1.0 / 40320.0; cp = cp * t2 - 1.0 / 720.0; cp = cp * t2 + 1.0 / 24.0; cp = cp * t2 - 0.5; cp = cp * t2 + 1.0;
    const double cs = cp;
    double co, si;
    switch (k & 3) { case 0: co = cs; si = sn; break; case 1: co = -sn; si = cs; break; case 2: co = -cs; si = -sn; break; default: co = sn; si = -cs; break; }
    c = (float)co; s = (float)si;
}

__global__ void __launch_bounds__(256) nv_prep(const float* __restrict__ x, const float* __restrict__ p, const int* __restrict__ pos, const float* __restrict__ g,
                                               const float* __restrict__ w_in, const float* __restrict__ bfg, bf16_t* XN, float* LF, float* COS, float* SIN, bf16_t* PB) {
    const int lane = threadIdx.x & 63, wid = threadIdx.x >> 6;
    for (int m = blockIdx.x * 4 + wid; m < T; m += gridDim.x * 4) {
        const f32x4* xr = (const f32x4*)(x + (size_t)m * DM) + lane;
        f32x4 v[8]; float ss = 0.f;
#pragma unroll
        for (int j = 0; j < 8; ++j) { v[j] = xr[64 * j]; ss += (v[j].x * v[j].x + v[j].y * v[j].y) + (v[j].z * v[j].z + v[j].w * v[j].w); }
        ss = wave_sum(ss);
        const float rstd = 1.0f / sqrtf(ss * (1.0f / DM) + EPS);
        float fa[8];
#pragma unroll
        for (int h = 0; h < 8; ++h) fa[h] = 0.f;
#pragma unroll
        for (int j = 0; j < 8; ++j) {
            const f32x4 gg = ((const f32x4*)g)[lane + 64 * j];
            f32x4 hv; hv.x = v[j].x * rstd * gg.x; hv.y = v[j].y * rstd * gg.y; hv.z = v[j].z * rstd * gg.z; hv.w = v[j].w * rstd * gg.w;
            u32x2 o; o.x = pk2(hv.x, hv.y); o.y = pk2(hv.z, hv.w);
            *((u32x2*)(XN + (size_t)m * DM) + lane + 64 * j) = o;
            const int k0 = 256 * j + 4 * lane;
#pragma unroll
            for (int i = 0; i < 4; ++i) {
                const float hk = i == 0 ? hv.x : i == 1 ? hv.y : i == 2 ? hv.z : hv.w;
                const f32x4 w0 = *(const f32x4*)(w_in + (size_t)(k0 + i) * NIN + C_F), w1 = *(const f32x4*)(w_in + (size_t)(k0 + i) * NIN + C_F + 4);
                fa[0] += hk * w0.x; fa[1] += hk * w0.y; fa[2] += hk * w0.z; fa[3] += hk * w0.w;
                fa[4] += hk * w1.x; fa[5] += hk * w1.y; fa[6] += hk * w1.z; fa[7] += hk * w1.w;
            }
        }
        const int b = m / SEQ, s = m % SEQ;
#pragma unroll
        for (int h = 0; h < 8; ++h) {
            const float f = wave_sum(fa[h]);
            if (lane == 0) { const float z = f + bfg[h]; LF[((size_t)b * FH + h) * SEQ + s] = fminf(z, 0.f) - log1pf(__expf(-fabsf(z))); }
        }
        if (lane < 32) {
            double rev = (double)pos[m] * INVF_REV[lane]; rev -= floor(rev);
            float c, sn; sincos_rev(rev, c, sn);
            COS[(size_t)m * 32 + lane] = c; SIN[(size_t)m * 32 + lane] = sn;
        }
        { const f32x4 pv = ((const f32x4*)(p + (size_t)m * PLE))[lane]; u32x2 o; o.x = pk2(pv.x, pv.y); o.y = pk2(pv.z, pv.w); *((u32x2*)(PB + (size_t)m * PLE) + lane) = o; }
    }
}
__global__ void __launch_bounds__(256) nv_cumsum(const float* __restrict__ LF, float* CS) {
    __shared__ double part[256];
    const int bh = blockIdx.x, tid = threadIdx.x;
    const float* src = LF + (size_t)bh * SEQ + tid * 16;
    double loc[16]; double run = 0.0;
#pragma unroll
    for (int i = 0; i < 16; ++i) { run += (double)src[i]; loc[i] = run; }
    part[tid] = run; __syncthreads();
    for (int o = 1; o < 256; o <<= 1) { double a = tid >= o ? part[tid - o] : 0.0; __syncthreads(); part[tid] += a; __syncthreads(); }
    const double base = tid ? part[tid - 1] : 0.0;
#pragma unroll
    for (int i = 0; i < 16; ++i) CS[(size_t)bh * SEQ + tid * 16 + i] = (float)((base + loc[i]) * 11.313708498984761);
}

enum { EPI_COPY = 0, EPI_SILU = 1, EPI_SIGM = 2, EPI_ROPE = 3, EPI_GATE1 = 4, EPI_GATE2 = 5, EPI_F32 = 6, EPI_FINAL = 7 };
struct NvGemm { const bf16_t* A; int lda; const float* B; int ldb; int bcol0; int M, N, K; int epi; void* O; int ldo; const void* aux0; const void* aux1; };
__global__ void __launch_bounds__(256) nv_gemm(NvGemm g) {
    __shared__ float As[16][65], Bs[16][65];
    const int tid = threadIdx.x, tx = tid & 15, ty = tid >> 4;
    const int m0 = blockIdx.y * 64, n0 = blockIdx.x * 64;
    float acc[4][4] = {};
    for (int k0 = 0; k0 < g.K; k0 += 16) {
        { const int m = tid >> 2, kc = (tid & 3) * 4; const bf16_t* ap = g.A + (size_t)(m0 + m) * g.lda + k0 + kc;
          const u32x2 raw = *(const u32x2*)ap;
          As[kc + 0][m] = __uint_as_float(raw.x << 16); As[kc + 1][m] = __uint_as_float(raw.x & 0xffff0000u);
          As[kc + 2][m] = __uint_as_float(raw.y << 16); As[kc + 3][m] = __uint_as_float(raw.y & 0xffff0000u); }
#pragma unroll
        for (int i = 0; i < 4; ++i) { const int e = tid + 256 * i, kk = e >> 6, n = e & 63; Bs[kk][n] = bf2f((bf16_t)f2bf(g.B[(size_t)(k0 + kk) * g.ldb + g.bcol0 + n0 + n])); }
        __syncthreads();
#pragma unroll
        for (int kk = 0; kk < 16; ++kk) {
            float a[4], b[4];
#pragma unroll
            for (int i = 0; i < 4; ++i) { a[i] = As[kk][ty + 16 * i]; b[i] = Bs[kk][tx + 16 * i]; }
#pragma unroll
            for (int i = 0; i < 4; ++i)
#pragma unroll
                for (int j = 0; j < 4; ++j) acc[i][j] += a[i] * b[j];
        }
        __syncthreads();
    }
#pragma unroll
    for (int i = 0; i < 4; ++i) {
        const int row = m0 + ty + 16 * i;
        if (g.epi == EPI_ROPE) {
            const float* COS = (const float*)g.aux0; const float* SIN = (const float*)g.aux1; bf16_t* O = (bf16_t*)g.O;
#pragma unroll
            for (int j = 0; j < 2; ++j) { const int d = tx + 16 * j; const float c = COS[(size_t)row * 32 + d], s = SIN[(size_t)row * 32 + d];
                const float x1 = acc[i][j], x2 = acc[i][j + 2]; const int pp = 8 * (d >> 2) + (d & 3);
                O[(size_t)row * g.ldo + n0 + pp] = (bf16_t)f2bf(x1 * c - x2 * s); O[(size_t)row * g.ldo + n0 + pp + 4] = (bf16_t)f2bf(x2 * c + x1 * s); }
        } else {
#pragma unroll
            for (int j = 0; j < 4; ++j) { const int col = n0 + tx + 16 * j; const size_t idx = (size_t)row * g.ldo + col; const float v = acc[i][j];
                switch (g.epi) {
                    case EPI_COPY: ((bf16_t*)g.O)[idx] = (bf16_t)f2bf(v); break;
                    case EPI_SILU: ((bf16_t*)g.O)[idx] = (bf16_t)f2bf(v * sigmoidf_(v)); break;
                    case EPI_SIGM: ((bf16_t*)g.O)[idx] = (bf16_t)f2bf(sigmoidf_(v)); break;
                    case EPI_GATE1: ((bf16_t*)g.O)[idx] = (bf16_t)f2bf(bf2f(((const bf16_t*)g.aux0)[idx]) * v); break;
                    case EPI_GATE2: ((bf16_t*)g.O)[idx] = (bf16_t)f2bf(bf2f(((bf16_t*)g.O)[idx]) + bf2f(((const bf16_t*)g.aux0)[idx]) * v); break;
                    case EPI_F32: ((float*)g.O)[idx] = v; break;
                    default: ((float*)g.O)[idx] = ((float*)g.O)[idx] + sigmoidf_(v) * bf2f(((const bf16_t*)g.aux0)[idx]); break;
                } }
        }
    }
}
template <int DH, bool FOX>
__global__ void __launch_bounds__(256) nv_attn(const bf16_t* __restrict__ Q, const bf16_t* __restrict__ K, const bf16_t* __restrict__ V, int ldkv,
                                               const float* __restrict__ CS, const float* __restrict__ sinks, const bf16_t* __restrict__ Z, bf16_t* Y) {
    constexpr int NH = FOX ? FH : SQH; constexpr int PER = DH / 64;
    const float scale = FOX ? 0.08838834764831845f : 0.125f;
    __shared__ float qs[4][DH];
    const int lane = threadIdx.x & 63, wid = threadIdx.x >> 6;
    const int gw = blockIdx.x * 4 + wid;
    const int t = gw % SEQ, h = (gw / SEQ) % NH, b = gw / (SEQ * NH);
    const int kvh = FOX ? h : h / 8;
    const size_t qoff = (size_t)(b * SEQ + t) * 1024 + h * DH;
    for (int d = lane; d < DH; d += 64) qs[wid][d] = bf2f(Q[qoff + d]);
    __syncthreads();
    const float cst = FOX ? CS[((size_t)b * FH + h) * SEQ + t] : 0.f;
    const int lo = FOX ? 0 : (t - (WIN - 1) > 0 ? t - (WIN - 1) : 0);
    float m = -1e30f, l = 0.f, o[PER];
#pragma unroll
    for (int i = 0; i < PER; ++i) o[i] = 0.f;
    for (int s0 = lo; s0 <= t; s0 += 64) {
        const int s = s0 + lane; const bool valid = s <= t;
        float xv = -__builtin_inff();
        if (valid) { const bf16_t* kr = K + (size_t)(b * SEQ + s) * ldkv + kvh * DH; float dot = 0.f;
#pragma unroll
            for (int c = 0; c < DH / 8; ++c) { const u32x4 w = *(const u32x4*)(kr + c * 8);
                dot += qs[wid][c * 8 + 0] * __uint_as_float(w.x << 16) + qs[wid][c * 8 + 1] * __uint_as_float(w.x & 0xffff0000u);
                dot += qs[wid][c * 8 + 2] * __uint_as_float(w.y << 16) + qs[wid][c * 8 + 3] * __uint_as_float(w.y & 0xffff0000u);
                dot += qs[wid][c * 8 + 4] * __uint_as_float(w.z << 16) + qs[wid][c * 8 + 5] * __uint_as_float(w.z & 0xffff0000u);
                dot += qs[wid][c * 8 + 6] * __uint_as_float(w.w << 16) + qs[wid][c * 8 + 7] * __uint_as_float(w.w & 0xffff0000u); }
            xv = FOX ? (dot + (cst - CS[((size_t)b * FH + h) * SEQ + s])) * scale : dot * scale; }
        const float mn = fmaxf(m, wave_max(xv)); const float alpha = __expf(m - mn); const float pe = valid ? __expf(xv - mn) : 0.f;
        l = l * alpha + wave_sum(pe); m = mn;
#pragma unroll
        for (int i = 0; i < PER; ++i) o[i] *= alpha;
        const int cnt = (t - s0 + 1) < 64 ? (t - s0 + 1) : 64;
        for (int j = 0; j < cnt; ++j) { const float pj = __shfl(pe, j); const bf16_t* vr = V + (size_t)(b * SEQ + s0 + j) * ldkv + kvh * DH + lane * PER;
#pragma unroll
            for (int i = 0; i < PER; ++i) o[i] += pj * bf2f(vr[i]); }
    }
    if (!FOX) l += __expf(sinks[h] - m);
    const float rl = 1.0f / l;
#pragma unroll
    for (int i = 0; i < PER; ++i) { const size_t idx = qoff + lane * PER + i; Y[idx] = (bf16_t)f2bf(o[i] * rl * bf2f(Z[idx])); }
}
__global__ void __launch_bounds__(256) nv_post(const float* __restrict__ x, const float* __restrict__ OUTP, const float* __restrict__ g, float* out, bf16_t* XN2) {
    const int lane = threadIdx.x & 63, wid = threadIdx.x >> 6;
    for (int m = blockIdx.x * 4 + wid; m < T; m += gridDim.x * 4) {
        const f32x4* orow = (const f32x4*)(OUTP + (size_t)m * DM) + lane; const f32x4* xr = (const f32x4*)(x + (size_t)m * DM) + lane;
        f32x4 v[8]; float ss = 0.f;
#pragma unroll
        for (int j = 0; j < 8; ++j) { v[j] = orow[64 * j]; ss += (v[j].x * v[j].x + v[j].y * v[j].y) + (v[j].z * v[j].z + v[j].w * v[j].w); }
        ss = wave_sum(ss);
        const float rstd = 1.0f / sqrtf(ss * (1.0f / DM) + EPS);
#pragma unroll
        for (int j = 0; j < 8; ++j) { const f32x4 gg = ((const f32x4*)g)[lane + 64 * j]; const f32x4 xx = xr[64 * j]; f32x4 r;
            r.x = xx.x + v[j].x * rstd * gg.x; r.y = xx.y + v[j].y * rstd * gg.y; r.z = xx.z + v[j].z * rstd * gg.z; r.w = xx.w + v[j].w * rstd * gg.w;
            ((f32x4*)(out + (size_t)m * DM))[lane + 64 * j] = r; u32x2 o; o.x = pk2(r.x, r.y); o.y = pk2(r.z, r.w); *((u32x2*)(XN2 + (size_t)m * DM) + lane + 64 * j) = o; }
    }
}

static void nv_launch_gemm(hipStream_t st, const bf16_t* A, int lda, const float* B, int ldb, int bcol0, int M, int N, int K, int epi, void* O, int ldo, const void* a0, const void* a1) {
    NvGemm g{}; g.A = A; g.lda = lda; g.B = B; g.ldb = ldb; g.bcol0 = bcol0; g.M = M; g.N = N; g.K = K; g.epi = epi; g.O = O; g.ldo = ldo; g.aux0 = a0; g.aux1 = a1;
    nv_gemm<<<dim3(N / 64, M / 64), 256, 0, st>>>(g);
}

extern "C" void kernel_launch(void* const* d_in, const int* in_sizes, int n_in, void* d_out, int out_size, void* d_ws, size_t ws_size, hipStream_t stream) {
    if (n_in != 13 || in_sizes[0] != T * DM || out_size != T * DM || ws_size < WS_END) { fprintf(stderr, "kernel_launch: unexpected shapes (n_in %d, in0 %d, out %d, ws %zu)\n", n_in, n_in > 0 ? in_sizes[0] : -1, out_size, ws_size); return; }
    const float* x = (const float*)d_in[0]; const float* p = (const float*)d_in[1]; const int* pos = (const int*)d_in[2]; const float* pre_g = (const float*)d_in[3];
    const float* w_in = (const float*)d_in[4]; const float* b_f = (const float*)d_in[5]; const float* sinks = (const float*)d_in[6]; const float* w_of = (const float*)d_in[7];
    const float* w_os = (const float*)d_in[8]; const float* w_out = (const float*)d_in[9]; const float* post_g = (const float*)d_in[10]; const float* w_ple = (const float*)d_in[11]; const float* w_pg = (const float*)d_in[12];
    char* ws = (char*)d_ws; float* out = (float*)d_out;
    bf16_t* XN = (bf16_t*)(ws + WS_XN); float* CS = (float*)(ws + WS_CS); float* LF = (float*)(ws + WS_LF); float* COS = (float*)(ws + WS_COS); float* SIN = (float*)(ws + WS_SIN);
    bf16_t* PB = (bf16_t*)(ws + WS_PB); bf16_t* QA = (bf16_t*)(ws + WS_QA); bf16_t* KA = (bf16_t*)(ws + WS_KA); bf16_t* VA = (bf16_t*)(ws + WS_VA); bf16_t* ZA = (bf16_t*)(ws + WS_ZA);
    bf16_t* QB = (bf16_t*)(ws + WS_QB); bf16_t* KB = (bf16_t*)(ws + WS_KB); bf16_t* VB = (bf16_t*)(ws + WS_VB); bf16_t* ZB = (bf16_t*)(ws + WS_ZB);
    bf16_t* GA = (bf16_t*)(ws + WS_GA); bf16_t* GB = (bf16_t*)(ws + WS_GB); bf16_t* E = (bf16_t*)(ws + WS_E); bf16_t* YA = (bf16_t*)(ws + WS_YA); bf16_t* YB = (bf16_t*)(ws + WS_YB);
    bf16_t* MERGED = (bf16_t*)(ws + WS_XN); float* OUTP = (float*)(ws + WS_OUTP); bf16_t* XN2 = (bf16_t*)(ws + WS_XN);

    nv_prep<<<1024, 256, 0, stream>>>(x, p, pos, pre_g, w_in, b_f, XN, LF, COS, SIN, PB);
    nv_cumsum<<<BATCH * FH, 256, 0, stream>>>(LF, CS);
    nv_launch_gemm(stream, XN, DM, w_in, NIN, C_QA, T, 1024, DM, EPI_COPY, QA, 1024, nullptr, nullptr);
    nv_launch_gemm(stream, XN, DM, w_in, NIN, C_KA, T, 1024, DM, EPI_COPY, KA, 1024, nullptr, nullptr);
    nv_launch_gemm(stream, XN, DM, w_in, NIN, C_VA, T, 1024, DM, EPI_COPY, VA, 1024, nullptr, nullptr);
    nv_launch_gemm(stream, XN, DM, w_in, NIN, C_ZA, T, 1024, DM, EPI_SILU, ZA, 1024, nullptr, nullptr);
    nv_launch_gemm(stream, XN, DM, w_in, NIN, C_QB, T, 1024, DM, EPI_ROPE, QB, 1024, COS, SIN);
    nv_launch_gemm(stream, XN, DM, w_in, NIN, C_KB, T, 128, DM, EPI_ROPE, KB, 128, COS, SIN);
    nv_launch_gemm(stream, XN, DM, w_in, NIN, C_VB, T, 128, DM, EPI_COPY, VB, 128, nullptr, nullptr);
    nv_launch_gemm(stream, XN, DM, w_in, NIN, C_ZB, T, 1024, DM, EPI_SILU, ZB, 1024, nullptr, nullptr);
    nv_launch_gemm(stream, XN, DM, w_in, NIN, C_GA, T, 2048, DM, EPI_SIGM, GA, 2048, nullptr, nullptr);
    nv_launch_gemm(stream, XN, DM, w_in, NIN, C_GB, T, 2048, DM, EPI_SIGM, GB, 2048, nullptr, nullptr);
    nv_launch_gemm(stream, PB, PLE, w_ple, DM, 0, T, DM, PLE, EPI_COPY, E, DM, nullptr, nullptr);
    nv_attn<FD, true><<<BATCH * FH * SEQ / 4, 256, 0, stream>>>(QA, KA, VA, 1024, CS, nullptr, ZA, YA);
    nv_attn<SD, false><<<BATCH * SQH * SEQ / 4, 256, 0, stream>>>(QB, KB, VB, 128, nullptr, sinks, ZB, YB);
    nv_launch_gemm(stream, YA, 1024, w_of, DM, 0, T, DM, 1024, EPI_GATE1, MERGED, DM, GA, nullptr);
    nv_launch_gemm(stream, YB, 1024, w_os, DM, 0, T, DM, 1024, EPI_GATE2, MERGED, DM, GB, nullptr);
    nv_launch_gemm(stream, MERGED, DM, w_out, DM, 0, T, DM, DM, EPI_F32, OUTP, DM, nullptr, nullptr);
    nv_post<<<1024, 256, 0, stream>>>(x, OUTP, post_g, out, XN2);
    nv_launch_gemm(stream, XN2, DM, w_pg, DM, 0, T, DM, DM, EPI_FINAL, out, DM, E, nullptr);
}
```

```cpp
#include <hip/hip_runtime.h>
#include <cstdio>
#include <cstdint>

constexpr int BATCH = 2, SEQ = 4096, T = BATCH * SEQ, DM = 2048, NIN = 10504;
constexpr int FH = 8, FD = 128, FW = 1024;
constexpr int SQH = 16, SKH = 2, SD = 64, SW = 1024, SKW = 128, WIN = 128;
constexpr int PLE = 256;
constexpr float EPS = 1e-6f;
constexpr int C_QA = 0, C_KA = 1024, C_VA = 2048, C_ZA = 3072, C_F = 4096, C_QB = 4104, C_KB = 5128, C_VB = 5256, C_ZB = 5384, C_GA = 6408, C_GB = 8456;

typedef unsigned short bf16_t;
typedef float f32x4 __attribute__((ext_vector_type(4)));
typedef unsigned u32x4 __attribute__((ext_vector_type(4)));
typedef unsigned u32x2 __attribute__((ext_vector_type(2)));

__device__ __forceinline__ float bf2f(bf16_t v) { return __uint_as_float(((unsigned)v) << 16); }
__device__ __forceinline__ unsigned f2bf(float f) { unsigned u = __float_as_uint(f); return (u + 0x7fffu + ((u >> 16) & 1u)) >> 16; }
__device__ __forceinline__ unsigned pk2(float lo, float hi) { return f2bf(lo) | (f2bf(hi) << 16); }
__device__ __forceinline__ float sigmoidf_(float x) { return 1.0f / (1.0f + __expf(-x)); }

constexpr size_t MiB = 1u << 20;
constexpr size_t WS_CTL = 0;
constexpr size_t WS_CS = 1 * MiB;
constexpr size_t WS_LF = 1 * MiB + 512 * 1024;
constexpr size_t WS_COS = 2 * MiB, WS_SIN = 3 * MiB;
constexpr size_t WS_WOF = 4 * MiB, WS_WOS = 8 * MiB, WS_WOUT = 12 * MiB, WS_WG = 20 * MiB, WS_WPLE = 28 * MiB;
constexpr size_t WS_PB = 29 * MiB;
constexpr size_t WS_WIN = 33 * MiB;
constexpr size_t WS_YA = 33 * MiB, WS_YB = 49 * MiB;
constexpr size_t WS_XN = 74 * MiB;
constexpr size_t WS_QA = 106 * MiB, WS_KA = 122 * MiB, WS_VA = 138 * MiB, WS_ZA = 154 * MiB;
constexpr size_t WS_OUTP = 106 * MiB;
constexpr size_t WS_QB = 170 * MiB, WS_KB = 186 * MiB, WS_VB = 188 * MiB, WS_ZB = 190 * MiB;
constexpr size_t WS_GA = 206 * MiB, WS_GB = 238 * MiB, WS_E = 270 * MiB, WS_END = 302 * MiB;

__constant__ double INVF_REV[32] = {0.15915494309189535,0.11934937021124886,0.08949940160889101,0.06711508300522726,0.050329212104487035,0.03774158471741977,0.0283021958306234,0.02122365276477766,0.015915494309189534,0.011934937021124886,0.008949940160889102,0.006711508300522725,0.005032921210448704,0.003774158471741977,0.00283021958306234,0.0021223652764777662,0.0015915494309189536,0.0011934937021124885,0.0008949940160889102,0.0006711508300522726,0.0005032921210448703,0.00037741584717419774,0.00028302195830623395,0.0002122365276477766,0.00015915494309189535,0.00011934937021124886,8.949940160889102e-05,6.711508300522725e-05,5.0329212104487035e-05,3.774158471741978e-05,2.8302195830623396e-05,2.122365276477766e-05};

__device__ __forceinline__ float wave_sum(float v) {
#pragma unroll
    for (int o = 1; o < 64; o <<= 1) v += __shfl_xor(v, o);
    return v;
}
__device__ __forceinline__ float wave_max(float v) {
#pragma unroll
    for (int o = 1; o < 64; o <<= 1) v = fmaxf(v, __shfl_xor(v, o));
    return v;
}
__device__ __forceinline__ void sincos_rev(double rev, float& c, float& s) {
    const int k = (int)(rev * 4.0 + 0.5);
    const double th = (rev - 0.25 * (double)k) * 6.283185307179586476925;
    const double t2 = th * th;
    double sp = -1.0 / 1307674368000.0;
    sp = sp * t2 + 1.0 / 6227020800.0; sp = sp * t2 - 1.0 / 39916800.0; sp = sp * t2 + 1.0 / 362880.0; sp = sp * t2 - 1.0 / 5040.0; sp = sp * t2 + 1.0 / 120.0; sp = sp * t2 - 1.0 / 6.0; sp = sp * t2 + 1.0;
    const double sn = sp * th;
    double cp = 1.0 / 20922789888000.0;
    cp = cp * t2 - 1.0 / 87178291200.0; cp = cp * t2 + 1.0 / 479001600.0; cp = cp * t2 - 1.0 / 3628800.0; cp = cp * t2 + 1.0 / 40320.0; cp = cp * t2 - 1.0 / 720.0; cp = cp * t2 + 1.0 / 24.0; cp = cp * t2 - 0.5; cp = cp * t2 + 1.0;
    const double cs = cp;
    double co, si;
    switch (k & 3) { case 0: co = cs; si = sn; break; case 1: co = -sn; si = cs; break; case 2: co = -cs; si = -sn; break; default: co = sn; si = -cs; break; }
    c = (float)co; s = (float)si;
}

__global__ void __launch_bounds__(256) nv_prep(const float* __restrict__ x, const float* __restrict__ p, const int* __restrict__ pos, const float* __restrict__ g,
                                               const float* __restrict__ w_in, const float* __restrict__ bfg, bf16_t* XN, float* LF, float* COS, float* SIN, bf16_t* PB) {
    const int lane = threadIdx.x & 63, wid = threadIdx.x >> 6;
    for (int m = blockIdx.x * 4 + wid; m < T; m += gridDim.x * 4) {
        const f32x4* xr = (const f32x4*)(x + (size_t)m * DM) + lane;
        f32x4 v[8]; float ss = 0.f;
#pragma unroll
        for (int j = 0; j < 8; ++j) { v[j] = xr[64 * j]; ss += (v[j].x * v[j].x + v[j].y * v[j].y) + (v[j].z * v[j].z + v[j].w * v[j].w); }
        ss = wave_sum(ss);
        const float rstd = 1.0f / sqrtf(ss * (1.0f / DM) + EPS);
        float fa[8];
#pragma unroll
        for (int h = 0; h < 8; ++h) fa[h] = 0.f;
#pragma unroll
        for (int j = 0; j < 8; ++j) {
            const f32x4 gg = ((const f32x4*)g)[lane + 64 * j];
            f32x4 hv; hv.x = v[j].x * rstd * gg.x; hv.y = v[j].y * rstd * gg.y; hv.z = v[j].z * rstd * gg.z; hv.w = v[j].w * rstd * gg.w;
            u32x2 o; o.x = pk2(hv.x, hv.y); o.y = pk2(hv.z, hv.w);
            *((u32x2*)(XN + (size_t)m * DM) + lane + 64 * j) = o;
            const int k0 = 256 * j + 4 * lane;
#pragma unroll
            for (int i = 0; i < 4; ++i) {
                const float hk = i == 0 ? hv.x : i == 1 ? hv.y : i == 2 ? hv.z : hv.w;
                const f32x4 w0 = *(const f32x4*)(w_in + (size_t)(k0 + i) * NIN + C_F), w1 = *(const f32x4*)(w_in + (size_t)(k0 + i) * NIN + C_F + 4);
                fa[0] += hk * w0.x; fa[1] += hk * w0.y; fa[2] += hk * w0.z; fa[3] += hk * w0.w;
                fa[4] += hk * w1.x; fa[5] += hk * w1.y; fa[6] += hk * w1.z; fa[7] += hk * w1.w;
            }
        }
        const int b = m / SEQ, s = m % SEQ;
#pragma unroll
        for (int h = 0; h < 8; ++h) {
            const float f = wave_sum(fa[h]);
            if (lane == 0) { const float z = f + bfg[h]; LF[((size_t)b * FH + h) * SEQ + s] = fminf(z, 0.f) - log1pf(__expf(-fabsf(z))); }
        }
        if (lane < 32) {
            double rev = (double)pos[m] * INVF_REV[lane]; rev -= floor(rev);
            float c, sn; sincos_rev(rev, c, sn);
            COS[(size_t)m * 32 + lane] = c; SIN[(size_t)m * 32 + lane] = sn;
        }
        { const f32x4 pv = ((const f32x4*)(p + (size_t)m * PLE))[lane]; u32x2 o; o.x = pk2(pv.x, pv.y); o.y = pk2(pv.z, pv.w); *((u32x2*)(PB + (size_t)m * PLE) + lane) = o; }
    }
}
__global__ void __launch_bounds__(256) nv_cumsum(const float* __restrict__ LF, float* CS) {
    __shared__ double part[256];
    const int bh = blockIdx.x, tid = threadIdx.x;
    const float* src = LF + (size_t)bh * SEQ + tid * 16;
    double loc[16]; double run = 0.0;
#pragma unroll
    for (int i = 0; i < 16; ++i) { run += (double)src[i]; loc[i] = run; }
    part[tid] = run; __syncthreads();
    for (int o = 1; o < 256; o <<= 1) { double a = tid >= o ? part[tid - o] : 0.0; __syncthreads(); part[tid] += a; __syncthreads(); }
    const double base = tid ? part[tid - 1] : 0.0;
#pragma unroll
    for (int i = 0; i < 16; ++i) CS[(size_t)bh * SEQ + tid * 16 + i] = (float)((base + loc[i]) * 11.313708498984761);
}

enum { EPI_COPY = 0, EPI_SILU = 1, EPI_SIGM = 2, EPI_ROPE = 3, EPI_GATE1 = 4, EPI_GATE2 = 5, EPI_F32 = 6, EPI_FINAL = 7 };
struct NvGemm { const bf16_t* A; int lda; const float* B; int ldb; int bcol0; int M, N, K; int epi; void* O; int ldo; const void* aux0; const void* aux1; };
__global__ void __launch_bounds__(256) nv_gemm(NvGemm g) {
    __shared__ float As[16][65], Bs[16][65];
    const int tid = threadIdx.x, tx = tid & 15, ty = tid >> 4;
    const int m0 = blockIdx.y * 64, n0 = blockIdx.x * 64;
    float acc[4][4] = {};
    for (int k0 = 0; k0 < g.K; k0 += 16) {
        { const int m = tid >> 2, kc = (tid & 3) * 4; const bf16_t* ap = g.A + (size_t)(m0 + m) * g.lda + k0 + kc;
          const u32x2 raw = *(const u32x2*)ap;
          As[kc + 0][m] = __uint_as_float(raw.x << 16); As[kc + 1][m] = __uint_as_float(raw.x & 0xffff0000u);
          As[kc + 2][m] = __uint_as_float(raw.y << 16); As[kc + 3][m] = __uint_as_float(raw.y & 0xffff0000u); }
#pragma unroll
        for (int i = 0; i < 4; ++i) { const int e = tid + 256 * i, kk = e >> 6, n = e & 63; Bs[kk][n] = bf2f((bf16_t)f2bf(g.B[(size_t)(k0 + kk) * g.ldb + g.bcol0 + n0 + n])); }
        __syncthreads();
#pragma unroll
        for (int kk = 0; kk < 16; ++kk) {
            float a[4], b[4];
#pragma unroll
            for (int i = 0; i < 4; ++i) { a[i] = As[kk][ty + 16 * i]; b[i] = Bs[kk][tx + 16 * i]; }
#pragma unroll
            for (int i = 0; i < 4; ++i)
#pragma unroll
                for (int j = 0; j < 4; ++j) acc[i][j] += a[i] * b[j];
        }
        __syncthreads();
    }
#pragma unroll
    for (int i = 0; i < 4; ++i) {
        const int row = m0 + ty + 16 * i;
        if (g.epi == EPI_ROPE) {
            const float* COS = (const float*)g.aux0; const float* SIN = (const float*)g.aux1; bf16_t* O = (bf16_t*)g.O;
#pragma unroll
            for (int j = 0; j < 2; ++j) { const int d = tx + 16 * j; const float c = COS[(size_t)row * 32 + d], s = SIN[(size_t)row * 32 + d];
                const float x1 = acc[i][j], x2 = acc[i][j + 2]; const int pp = 8 * (d >> 2) + (d & 3);
                O[(size_t)row * g.ldo + n0 + pp] = (bf16_t)f2bf(x1 * c - x2 * s); O[(size_t)row * g.ldo + n0 + pp + 4] = (bf16_t)f2bf(x2 * c + x1 * s); }
        } else {
#pragma unroll
            for (int j = 0; j < 4; ++j) { const int col = n0 + tx + 16 * j; const size_t idx = (size_t)row * g.ldo + col; const float v = acc[i][j];
                switch (g.epi) {
                    case EPI_COPY: ((bf16_t*)g.O)[idx] = (bf16_t)f2bf(v); break;
                    case EPI_SILU: ((bf16_t*)g.O)[idx] = (bf16_t)f2bf(v * sigmoidf_(v)); break;
                    case EPI_SIGM: ((bf16_t*)g.O)[idx] = (bf16_t)f2bf(sigmoidf_(v)); break;
                    case EPI_GATE1: ((bf16_t*)g.O)[idx] = (bf16_t)f2bf(bf2f(((const bf16_t*)g.aux0)[idx]) * v); break;
                    case EPI_GATE2: ((bf16_t*)g.O)[idx] = (bf16_t)f2bf(bf2f(((bf16_t*)g.O)[idx]) + bf2f(((const bf16_t*)g.aux0)[idx]) * v); break;
                    case EPI_F32: ((float*)g.O)[idx] = v; break;
                    default: ((float*)g.O)[idx] = ((float*)g.O)[idx] + sigmoidf_(v) * bf2f(((const bf16_t*)g.aux0)[idx]); break;
                } }
        }
    }
}
template <int DH, bool FOX>
__global__ void __launch_bounds__(256) nv_attn(const bf16_t* __restrict__ Q, const bf16_t* __restrict__ K, const bf16_t* __restrict__ V, int ldkv,
                                               const float* __restrict__ CS, const float* __restrict__ sinks, const bf16_t* __restrict__ Z, bf16_t* Y) {
    constexpr int NH = FOX ? FH : SQH; constexpr int PER = DH / 64;
    const float scale = FOX ? 0.08838834764831845f : 0.125f;
    __shared__ float qs[4][DH];
    const int lane = threadIdx.x & 63, wid = threadIdx.x >> 6;
    const int gw = blockIdx.x * 4 + wid;
    const int t = gw % SEQ, h = (gw / SEQ) % NH, b = gw / (SEQ * NH);
    const int kvh = FOX ? h : h / 8;
    const size_t qoff = (size_t)(b * SEQ + t) * 1024 + h * DH;
    for (int d = lane; d < DH; d += 64) qs[wid][d] = bf2f(Q[qoff + d]);
    __syncthreads();
    const float cst = FOX ? CS[((size_t)b * FH + h) * SEQ + t] : 0.f;
    const int lo = FOX ? 0 : (t - (WIN - 1) > 0 ? t - (WIN - 1) : 0);
    float m = -1e30f, l = 0.f, o[PER];
#pragma unroll
    for (int i = 0; i < PER; ++i) o[i] = 0.f;
    for (int s0 = lo; s0 <= t; s0 += 64) {
        const int s = s0 + lane; const bool valid = s <= t;
        float xv = -__builtin_inff();
        if (valid) { const bf16_t* kr = K + (size_t)(b * SEQ + s) * ldkv + kvh * DH; float dot = 0.f;
#pragma unroll
            for (int c = 0; c < DH / 8; ++c) { const u32x4 w = *(const u32x4*)(kr + c * 8);
                dot += qs[wid][c * 8 + 0] * __uint_as_float(w.x << 16) + qs[wid][c * 8 + 1] * __uint_as_float(w.x & 0xffff0000u);
                dot += qs[wid][c * 8 + 2] * __uint_as_float(w.y << 16) + qs[wid][c * 8 + 3] * __uint_as_float(w.y & 0xffff0000u);
                dot += qs[wid][c * 8 + 4] * __uint_as_float(w.z << 16) + qs[wid][c * 8 + 5] * __uint_as_float(w.z & 0xffff0000u);
                dot += qs[wid][c * 8 + 6] * __uint_as_float(w.w << 16) + qs[wid][c * 8 + 7] * __uint_as_float(w.w & 0xffff0000u); }
            xv = FOX ? (dot + (cst - CS[((size_t)b * FH + h) * SEQ + s])) * scale : dot * scale; }
        const float mn = fmaxf(m, wave_max(xv)); const float alpha = __expf(m - mn); const float pe = valid ? __expf(xv - mn) : 0.f;
        l = l * alpha + wave_sum(pe); m = mn;
#pragma unroll
        for (int i = 0; i < PER; ++i) o[i] *= alpha;
        const int cnt = (t - s0 + 1) < 64 ? (t - s0 + 1) : 64;
        for (int j = 0; j < cnt; ++j) { const float pj = __shfl(pe, j); const bf16_t* vr = V + (size_t)(b * SEQ + s0 + j) * ldkv + kvh * DH + lane * PER;
#pragma unroll
            for (int i = 0; i < PER; ++i) o[i] += pj * bf2f(vr[i]); }
    }
    if (!FOX) l += __expf(sinks[h] - m);
    const float rl = 1.0f / l;
#pragma unroll
    for (int i = 0; i < PER; ++i) { const size_t idx = qoff + lane * PER + i; Y[idx] = (bf16_t)f2bf(o[i] * rl * bf2f(Z[idx])); }
}
__global__ void __launch_bounds__(256) nv_post(const float* __restrict__ x, const float* __restrict__ OUTP, const float* __restrict__ g, float* out, bf16_t* XN2) {
    const int lane = threadIdx.x & 63, wid = threadIdx.x >> 6;
    for (int m = blockIdx.x * 4 + wid; m < T; m += gridDim.x * 4) {
        const f32x4* orow = (const f32x4*)(OUTP + (size_t)m * DM) + lane; const f32x4* xr = (const f32x4*)(x + (size_t)m * DM) + lane;
        f32x4 v[8]; float ss = 0.f;
#pragma unroll
        for (int j = 0; j < 8; ++j) { v[j] = orow[64 * j]; ss += (v[j].x * v[j].x + v[j].y * v[j].y) + (v[j].z * v[j].z + v[j].w * v[j].w); }
        ss = wave_sum(ss);
        const float rstd = 1.0f / sqrtf(ss * (1.0f / DM) + EPS);
#pragma unroll
        for (int j = 0; j < 8; ++j) { const f32x4 gg = ((const f32x4*)g)[lane + 64 * j]; const f32x4 xx = xr[64 * j]; f32x4 r;
            r.x = xx.x + v[j].x * rstd * gg.x; r.y = xx.y + v[j].y * rstd * gg.y; r.z = xx.z + v[j].z * rstd * gg.z; r.w = xx.w + v[j].w * rstd * gg.w;
            ((f32x4*)(out + (size_t)m * DM))[lane + 64 * j] = r; u32x2 o; o.x = pk2(r.x, r.y); o.y = pk2(r.z, r.w); *((u32x2*)(XN2 + (size_t)m * DM) + lane + 64 * j) = o; }
    }
}

#define MK_MASK 0x7f
namespace pg8 {
#define PG8_LAS __attribute__((address_space(3)))
typedef unsigned short bf16_t;
typedef short bf16x8 __attribute__((ext_vector_type(8)));
typedef float f32x4 __attribute__((ext_vector_type(4)));
typedef unsigned u32x4 __attribute__((ext_vector_type(4)));
constexpr int BM = 256, BK = 64, HALF = 128, HTB = HALF * BK * 2  , STAGE_BYTES = 8 * HTB, NXCD = 8, WGM = 8;

__host__ __device__ __forceinline__ int lds_byte(int r, int c) { const int st = (r >> 4) * 2 + (c >> 5), rr = r & 15, cc = c & 31, ob = rr * 64 + cc * 2; return st * 1024 + (ob ^ (((ob >> 9) & 1) << 5)); }
__host__ __device__ __forceinline__ void stage_rc(int b, int& R, int& C) { const int st = b / 1024, sb = b % 1024, swz = sb ^ (((sb >> 9) & 1) << 5); R = (st >> 1) * 16 + swz / 64; C = (st & 1) * 32 + (swz % 64) / 2; }
__host__ __device__ __forceinline__ int perm32(int rho) { const int n = rho >> 4, i = rho & 15; return 8 * (i >> 2) + 4 * n + (i & 3); }

struct Unit { int pm, pn; };
struct Gemm { const bf16_t* A; const bf16_t* Bt; int M, N, K; };

struct StaticOrder {
    int nM, nN, nwg, G, c;
    __host__ __device__ void init(int M, int N, int G_, int c_) { nM = M / BM; nN = N / BM; nwg = nM * nN; G = G_; c = c_; }
    __host__ __device__ bool next(int i, Unit& u) const {
        const long L = (long)i * G + c; if (L >= nwg) return false;
        int wgid = (int)L; { const int q = nwg / NXCD, r = nwg % NXCD, xcd = wgid % NXCD, off = wgid / NXCD; wgid = (xcd < r ? xcd * (q + 1) : r * (q + 1) + (xcd - r) * q) + off; }
        const int nig = WGM * nN, gid = wgid / nig, fm = gid * WGM, gsz = (nM - fm) < WGM ? (nM - fm) : WGM;
        u.pm = fm + ((wgid % nig) % gsz); u.pn = (wgid % nig) / gsz; return true;
    }
    __device__ __forceinline__ void a_ready(const Unit&) const {}
    __device__ __forceinline__ void done(const Unit&) const {}
};

typedef float f32x2_t __attribute__((ext_vector_type(2))); typedef __bf16 bf16x2_t __attribute__((ext_vector_type(2)));
__device__ __forceinline__ unsigned cvt_pk_bf16(float lo, float hi) { f32x2_t v = {lo, hi}; bf16x2_t b = __builtin_convertvector(v, bf16x2_t); return __builtin_bit_cast(unsigned, b); }
__device__ __forceinline__ float fsigm(float x) { return __builtin_amdgcn_rcpf(1.0f + __builtin_amdgcn_exp2f(-1.4426950408889634f * x)); }
__device__ __forceinline__ f32x4 sigm4(f32x4 v) { return (f32x4){fsigm(v[0]), fsigm(v[1]), fsigm(v[2]), fsigm(v[3])}; }
__device__ __forceinline__ void store8bf(bf16_t* p, f32x4 v0, f32x4 v1) { u32x4 w; w.x = cvt_pk_bf16(v0[0], v0[1]); w.y = cvt_pk_bf16(v0[2], v0[3]); w.z = cvt_pk_bf16(v1[0], v1[1]); w.w = cvt_pk_bf16(v1[2], v1[3]); *(u32x4*)p = w; }
__device__ __forceinline__ void load8bf(const bf16_t* p, f32x4& v0, f32x4& v1) { const u32x4 w = *(const u32x4*)p;
    v0 = (f32x4){__uint_as_float(w.x << 16), __uint_as_float(w.x & 0xffff0000u), __uint_as_float(w.y << 16), __uint_as_float(w.y & 0xffff0000u)};
    v1 = (f32x4){__uint_as_float(w.z << 16), __uint_as_float(w.z & 0xffff0000u), __uint_as_float(w.w << 16), __uint_as_float(w.w & 0xffff0000u)}; }

struct EpiProj {
    static constexpr bool PERM = true, AFTER_DRAIN = false;
    unsigned char* ws;
    __device__ __forceinline__ void operator()(const f32x4 (&acc)[2][2][4][2], const Unit& u, int wr, int wc, int fr, int fq) const {
        const int pn = u.pn, row0 = u.pm * BM + wr * 64 + fr, cl = wc * 32 + 8 * fq, d0 = 16 * (wc & 1) + 4 * fq;
        const float* COS = (const float*)(ws + WS_COS); const float* SIN = (const float*)(ws + WS_SIN);
#pragma unroll
        for (int bj = 0; bj < 2; ++bj) {
            size_t off; int ld = 1024, col, kind;
            if (pn < 4)        { off = WS_QA; col = pn * 256; kind = 0; }
            else if (pn < 8)   { off = WS_KA; col = (pn - 4) * 256; kind = 0; }
            else if (pn < 12)  { off = WS_VA; col = (pn - 8) * 256; kind = 0; }
            else if (pn < 16)  { off = WS_ZA; col = (pn - 12) * 256; kind = 1; }
            else if (pn < 20)  { off = WS_QB; col = (pn - 16) * 256; kind = 3; }
            else if (pn == 20) { ld = 128; if (bj == 0) { off = WS_KB; col = 0; kind = 3; } else { off = WS_VB; col = -128; kind = 0; } }
            else if (pn < 25)  { off = WS_ZB; col = (pn - 21) * 256; kind = 1; }
            else if (pn < 33)  { off = WS_GA; ld = 2048; col = (pn - 25) * 256; kind = 2; }
            else               { off = WS_GB; ld = 2048; col = (pn - 33) * 256; kind = 2; }
            bf16_t* base = (bf16_t*)(ws + off);
            col += bj * HALF + cl;
#pragma unroll
            for (int ai = 0; ai < 2; ++ai)
#pragma unroll
                for (int m = 0; m < 4; ++m) {
                    const int row = row0 + ai * HALF + m * 16;
                    f32x4 v0 = acc[ai][bj][m][0], v1 = acc[ai][bj][m][1];
                    if (kind == 3) { const f32x4 c4 = *(const f32x4*)(COS + (size_t)row * 32 + d0), s4 = *(const f32x4*)(SIN + (size_t)row * 32 + d0);
                        const f32x4 o1 = v0 * c4 - v1 * s4, o2 = v1 * c4 + v0 * s4; v0 = o1; v1 = o2; }
                    else if (kind == 1) { v0 = v0 * sigm4(v0); v1 = v1 * sigm4(v1); }
                    else if (kind == 2) { v0 = sigm4(v0); v1 = sigm4(v1); }
                    store8bf(base + (size_t)row * ld + col, v0, v1);
                    if (kind == 3) asm volatile("" ::: "memory");
                }
        }
    }
};
struct EpiCopy {
    static constexpr bool PERM = true, AFTER_DRAIN = false;
    bf16_t* O; int ld;
    __device__ __forceinline__ void operator()(const f32x4 (&acc)[2][2][4][2], const Unit& u, int wr, int wc, int fr, int fq) const {
        const int row0 = u.pm * BM + wr * 64 + fr, col0 = u.pn * BM + wc * 32 + 8 * fq;
#pragma unroll
        for (int ai = 0; ai < 2; ++ai)
#pragma unroll
            for (int m = 0; m < 4; ++m)
#pragma unroll
                for (int bj = 0; bj < 2; ++bj) store8bf(O + (size_t)(row0 + ai * HALF + m * 16) * ld + col0 + bj * HALF, acc[ai][bj][m][0], acc[ai][bj][m][1]);
    }
};
template <int MODE> struct EpiGate {
    static constexpr bool PERM = true, AFTER_DRAIN = false;
    bf16_t* O; const bf16_t* G;
    __device__ __forceinline__ void operator()(const f32x4 (&acc)[2][2][4][2], const Unit& u, int wr, int wc, int fr, int fq) const {
        const int row0 = u.pm * BM + wr * 64 + fr, col0 = u.pn * BM + wc * 32 + 8 * fq;
#pragma unroll
        for (int ai = 0; ai < 2; ++ai)
#pragma unroll
            for (int m = 0; m < 4; ++m)
#pragma unroll
                for (int bj = 0; bj < 2; ++bj) { const size_t idx = (size_t)(row0 + ai * HALF + m * 16) * 2048 + col0 + bj * HALF;
                    f32x4 g0, g1; load8bf(G + idx, g0, g1); f32x4 v0 = g0 * acc[ai][bj][m][0], v1 = g1 * acc[ai][bj][m][1];
                    if (MODE == 1) { f32x4 t0, t1; load8bf(O + idx, t0, t1); v0 = v0 + t0; v1 = v1 + t1; }
                    store8bf(O + idx, v0, v1); }
    }
};
struct EpiF32 {
    static constexpr bool PERM = true, AFTER_DRAIN = false;
    float* O;
    __device__ __forceinline__ void operator()(const f32x4 (&acc)[2][2][4][2], const Unit& u, int wr, int wc, int fr, int fq) const {
        const int row0 = u.pm * BM + wr * 64 + fr, col0 = u.pn * BM + wc * 32 + 8 * fq;
#pragma unroll
        for (int ai = 0; ai < 2; ++ai)
#pragma unroll
            for (int m = 0; m < 4; ++m)
#pragma unroll
                for (int bj = 0; bj < 2; ++bj) { float* p = O + (size_t)(row0 + ai * HALF + m * 16) * 2048 + col0 + bj * HALF; *(f32x4*)p = acc[ai][bj][m][0]; *(f32x4*)(p + 4) = acc[ai][bj][m][1]; }
    }
};
struct EpiFinal {
    static constexpr bool PERM = true, AFTER_DRAIN = false;
    float* O; const bf16_t* E;
    __device__ __forceinline__ void operator()(const f32x4 (&acc)[2][2][4][2], const Unit& u, int wr, int wc, int fr, int fq) const {
        const int row0 = u.pm * BM + wr * 64 + fr, col0 = u.pn * BM + wc * 32 + 8 * fq;
#pragma unroll
        for (int ai = 0; ai < 2; ++ai)
#pragma unroll
            for (int m = 0; m < 4; ++m)
#pragma unroll
                for (int bj = 0; bj < 2; ++bj) { const size_t idx = (size_t)(row0 + ai * HALF + m * 16) * 2048 + col0 + bj * HALF;
                    f32x4 e0, e1; load8bf(E + idx, e0, e1); float* p = O + idx; const f32x4 x0 = *(const f32x4*)p, x1 = *(const f32x4*)(p + 4);
                    *(f32x4*)p = x0 + sigm4(acc[ai][bj][m][0]) * e0; *(f32x4*)(p + 4) = x1 + sigm4(acc[ai][bj][m][1]) * e1; }
    }
};

template <class Epi, class Sched, bool ALIGN_EPI = false, bool SP2 = false>
__device__ __forceinline__ void gemm_phase(PG8_LAS unsigned char* lds, const Gemm g, const Sched& S, const Epi& E) {
    int tid_ = threadIdx.x; asm volatile("" : "+v"(tid_));
    const int tid = tid_, wid = __builtin_amdgcn_readfirstlane(tid >> 6), lane = tid & 63, wr = wid >> 2, wc = wid & 3, fr = lane & 15, fq = lane >> 4;
    const int K = g.K, nt = K / BK;
    unsigned voffA[2], voffB[2];
#pragma unroll
    for (int i = 0; i < 2; ++i) { int R, C; stage_rc(tid * 16 + i * 8192, R, C); const int Rb = Epi::PERM ? ((R & ~31) + perm32(R & 31)) : R;
        voffA[i] = (unsigned)(R * K + C) * 2u; voffB[i] = (unsigned)(Rb * K + C) * 2u; }
    const size_t kstep = (size_t)(BK * 2);
    const size_t hstep = (size_t)HALF * K * 2;
    const size_t tstep = 2 * hstep;
    const unsigned ldsw = (unsigned)wid * 1024u;
    const int aoff = lds_byte(wr * 64 + fr, fq * 8), boff = lds_byte(wc * 32 + fr, fq * 8);
#define PG8_SA(b, h) (((b) * 2 + (h)) * HTB)
#define PG8_SB(b, h) ((4 + (b) * 2 + (h)) * HTB)
#define PG8_STAGE(bufoff, gbase, voff) do { _Pragma("unroll") for (int _i = 0; _i < 2; ++_i) \
        __builtin_amdgcn_global_load_lds((const unsigned*)((const char*)(gbase) + (voff)[_i]), (PG8_LAS unsigned*)(lds + (bufoff) + ldsw + _i * 8192), 16, 0, 0); } while (0)
#define PG8_LDA(dst, b, h) do { _Pragma("unroll") for (int m = 0; m < 4; ++m) _Pragma("unroll") for (int k = 0; k < 2; ++k) dst[m][k] = *(const PG8_LAS bf16x8*)(lds + PG8_SA(b, h) + aoff + m * 2048 + k * 1024); } while (0)
#define PG8_LDB(dst, b, h) do { _Pragma("unroll") for (int n = 0; n < 2; ++n) _Pragma("unroll") for (int k = 0; k < 2; ++k) dst[n][k] = *(const PG8_LAS bf16x8*)(lds + PG8_SB(b, h) + boff + n * 2048 + k * 1024); } while (0)
#define PG8_MMA(ai, bj, At, Bt) do { __builtin_amdgcn_s_setprio(1); _Pragma("unroll") for (int m = 0; m < 4; ++m) _Pragma("unroll") for (int n = 0; n < 2; ++n) _Pragma("unroll") for (int k = 0; k < 2; ++k) \
        acc[ai][bj][m][n] = __builtin_amdgcn_mfma_f32_16x16x32_bf16(Bt[n][k], At[m][k], acc[ai][bj][m][n], 0, 0, 0); __builtin_amdgcn_s_setprio(0); } while (0)
#define PG8_WAIT_V(n) asm volatile("s_waitcnt vmcnt(" #n ")" ::: "memory")
#define PG8_WAIT_L(n) asm volatile("s_waitcnt lgkmcnt(" #n ")" ::: "memory")
#define PG8_BAR __builtin_amdgcn_s_barrier()
#define PG8_SCHED __builtin_amdgcn_sched_barrier(0)
    Unit cur, nxt; int ui = 0;
    if (!S.next(0, cur)) return;
    f32x4 acc[2][2][4][2];
#pragma unroll
    for (int a = 0; a < 2; ++a)
#pragma unroll
        for (int b = 0; b < 2; ++b)
#pragma unroll
            for (int m = 0; m < 4; ++m)
#pragma unroll
                for (int n = 0; n < 2; ++n) acc[a][b][m][n] = (f32x4){0.f, 0.f, 0.f, 0.f};
    bf16x8 At[4][2], B0[2][2], B1[2][2];
    const char* cA = (const char*)g.A + (size_t)cur.pm * tstep; const char* cB = (const char*)g.Bt + (size_t)cur.pn * tstep;
    S.a_ready(cur);
    if constexpr (SP2) {
        PG8_STAGE(PG8_SB(0, 0), cB, voffB); PG8_STAGE(PG8_SB(0, 1), cB + hstep, voffB); PG8_STAGE(PG8_SA(0, 0), cA, voffA); PG8_STAGE(PG8_SA(0, 1), cA + hstep, voffA);
        if (wr == 1) PG8_BAR;
        PG8_WAIT_V(2); PG8_BAR;
        PG8_STAGE(PG8_SB(1, 0), cB + kstep, voffB); PG8_STAGE(PG8_SA(1, 0), cA + kstep, voffA); PG8_STAGE(PG8_SB(1, 1), cB + hstep + kstep, voffB);
        PG8_WAIT_V(6); PG8_BAR;
    } else {
        PG8_STAGE(PG8_SB(0, 0), cB, voffB); PG8_STAGE(PG8_SA(0, 0), cA, voffA); PG8_STAGE(PG8_SB(0, 1), cB + hstep, voffB); PG8_STAGE(PG8_SA(0, 1), cA + hstep, voffA);
        if (wr == 1) PG8_BAR;
        PG8_WAIT_V(4); PG8_BAR;
        PG8_STAGE(PG8_SB(1, 0), cB + kstep, voffB); PG8_STAGE(PG8_SA(1, 0), cA + kstep, voffA); PG8_STAGE(PG8_SB(1, 1), cB + hstep + kstep, voffB);
        PG8_WAIT_V(6); PG8_BAR;
    }
    for (;;) {
        const bool has_next = S.next(ui + 1, nxt);
        const char* nA = has_next ? (const char*)g.A + (size_t)nxt.pm * tstep : cA; const char* nB = has_next ? (const char*)g.Bt + (size_t)nxt.pn * tstep : cB;
        for (int t = 0; t < nt; t += 2) {
            const bool last = (t == nt - 2);
            const char* a1 = cA + (size_t)(t + 1) * kstep;
            const char* a2 = last ? nA : cA + (size_t)(t + 2) * kstep; const char* b2 = last ? nB : cB + (size_t)(t + 2) * kstep;
            const char* a3 = a2 + kstep; const char* b3 = b2 + kstep;
            if (last && has_next) S.a_ready(nxt);
            if constexpr (SP2) {
            PG8_LDB(B0, 0, 0); PG8_LDB(B1, 0, 1); PG8_SCHED; PG8_LDA(At, 0, 0); PG8_STAGE(PG8_SA(1, 1), a1 + hstep, voffA);
            PG8_WAIT_V(8); PG8_WAIT_L(0); PG8_BAR; PG8_MMA(0, 0, At, B0); PG8_MMA(0, 1, At, B1); PG8_BAR; PG8_SCHED;
            PG8_LDA(At, 0, 1); PG8_STAGE(PG8_SB(0, 0), b2, voffB); PG8_STAGE(PG8_SB(0, 1), b2 + hstep, voffB); PG8_STAGE(PG8_SA(0, 0), a2, voffA);
            PG8_WAIT_V(8); PG8_WAIT_L(0); PG8_BAR; PG8_MMA(1, 0, At, B0); PG8_MMA(1, 1, At, B1); PG8_BAR; PG8_SCHED;
            PG8_LDB(B0, 1, 0); PG8_LDB(B1, 1, 1); PG8_SCHED; PG8_LDA(At, 1, 0); PG8_STAGE(PG8_SA(0, 1), a2 + hstep, voffA);
            PG8_WAIT_V(8); PG8_WAIT_L(0); PG8_BAR; PG8_MMA(0, 0, At, B0); PG8_MMA(0, 1, At, B1); PG8_BAR; PG8_SCHED;
            PG8_LDA(At, 1, 1); PG8_STAGE(PG8_SB(1, 0), b3, voffB); PG8_STAGE(PG8_SB(1, 1), b3 + hstep, voffB); PG8_STAGE(PG8_SA(1, 0), a3, voffA);
            PG8_WAIT_V(8); PG8_WAIT_L(0); PG8_BAR; PG8_MMA(1, 0, At, B0); PG8_MMA(1, 1, At, B1); PG8_BAR; PG8_SCHED;
            } else {
            PG8_LDB(B0, 0, 0); PG8_SCHED; PG8_LDA(At, 0, 0); PG8_STAGE(PG8_SA(1, 1), a1 + hstep, voffA);
            PG8_WAIT_L(8); PG8_BAR; PG8_WAIT_L(0); PG8_MMA(0, 0, At, B0); PG8_BAR; PG8_SCHED;
            PG8_LDB(B1, 0, 1); PG8_STAGE(PG8_SB(0, 0), b2, voffB);
            PG8_BAR; PG8_WAIT_L(0); PG8_MMA(0, 1, At, B1); PG8_BAR;
            PG8_LDA(At, 0, 1); PG8_STAGE(PG8_SA(0, 0), a2, voffA);
            PG8_BAR; PG8_WAIT_L(0); PG8_MMA(1, 0, At, B0); PG8_BAR; PG8_SCHED;
            PG8_STAGE(PG8_SB(0, 1), b2 + hstep, voffB);
            PG8_WAIT_V(6); PG8_BAR; PG8_MMA(1, 1, At, B1); PG8_BAR;
            PG8_LDB(B0, 1, 0); PG8_SCHED; PG8_LDA(At, 1, 0); PG8_STAGE(PG8_SA(0, 1), a2 + hstep, voffA);
            PG8_WAIT_L(8); PG8_BAR; PG8_WAIT_L(0); PG8_MMA(0, 0, At, B0); PG8_BAR; PG8_SCHED;
            PG8_LDB(B1, 1, 1); PG8_STAGE(PG8_SB(1, 0), b3, voffB);
            PG8_BAR; PG8_WAIT_L(0); PG8_MMA(0, 1, At, B1); PG8_BAR;
            PG8_LDA(At, 1, 1); PG8_STAGE(PG8_SA(1, 0), a3, voffA);
            PG8_BAR; PG8_WAIT_L(0); PG8_MMA(1, 0, At, B0); PG8_BAR; PG8_SCHED;
            PG8_STAGE(PG8_SB(1, 1), b3 + hstep, voffB);
            PG8_WAIT_V(6); PG8_BAR; PG8_MMA(1, 1, At, B1); PG8_BAR;
            }
        }
        if constexpr (ALIGN_EPI) { if (wr == 0) PG8_BAR; }
        if constexpr (!Epi::AFTER_DRAIN) { E(acc, cur, wr, wc, fr, fq); S.done(cur); }
        if (!has_next) break;
#pragma unroll
        for (int a = 0; a < 2; ++a)
#pragma unroll
            for (int b = 0; b < 2; ++b)
#pragma unroll
                for (int m = 0; m < 4; ++m)
#pragma unroll
                    for (int n = 0; n < 2; ++n) acc[a][b][m][n] = (f32x4){0.f, 0.f, 0.f, 0.f};
        cur = nxt; cA = nA; cB = nB; ++ui;
        if constexpr (ALIGN_EPI) { if (wr == 1) PG8_BAR; }
    }
    PG8_WAIT_V(0);
    if constexpr (!ALIGN_EPI) { if (wr == 0) PG8_BAR; }
    PG8_BAR;
    if constexpr (Epi::AFTER_DRAIN) { E.fused(acc, cur, wr, wc, fr, fq, lds, wid, lane); S.done(cur); }
#undef PG8_SA
#undef PG8_SB
#undef PG8_STAGE
#undef PG8_LDA
#undef PG8_LDB
#undef PG8_MMA
#undef PG8_WAIT_V
#undef PG8_WAIT_L
#undef PG8_BAR
#undef PG8_SCHED
}
}
#define GAS __attribute__((address_space(1)))
#define LAS __attribute__((address_space(3)))
typedef GAS unsigned gu32;
#define RLX_AGENT __ATOMIC_RELAXED, __HIP_MEMORY_SCOPE_AGENT
#define LDS_WAIT() asm volatile("s_waitcnt lgkmcnt(0)" ::: "memory")
#define VM_WAIT() asm volatile("s_waitcnt vmcnt(0)" ::: "memory")
constexpr int NWAVES = 8;
#define XB_TMO      128
#define XB_XCNT(j)  (256  + 64 * (j))
#define XB_XSUB(j)  (1280 + 64 * (j))
#define XB_XGEN(j)  (2304 + 64 * (j))
#define XB_TOP      3328
#define XB_TOPGEN   3392
#define XCD_BAR_WORDS 3456
#define XB_SPIN_CAP (1u << 18)

__device__ __forceinline__ unsigned xb_ld(unsigned* p)              { return __hip_atomic_load(p, __ATOMIC_RELAXED, __HIP_MEMORY_SCOPE_AGENT); }
__device__ __forceinline__ unsigned xb_add(unsigned* p, unsigned v) { return __hip_atomic_fetch_add(p, v, __ATOMIC_RELAXED, __HIP_MEMORY_SCOPE_AGENT); }
__device__ __forceinline__ unsigned xb_xcc_id() { return (unsigned)__builtin_amdgcn_s_getreg((3 << 11) | 20) & 0xFu; }
#define XB_SPIN(cond, bar) do { unsigned _sp = 0; while (cond) { __builtin_amdgcn_s_sleep(1); \
    if ((++_sp & 255u) == 0u) { if (xb_ld(&(bar)[XB_TMO])) break; if (_sp > XB_SPIN_CAP) { atomicAdd(&(bar)[XB_TMO], 1u); break; } } } } while (0)

struct XcdBarrier {
    unsigned* bar; unsigned x;
    volatile LAS unsigned* st;
};

__device__ __forceinline__ XcdBarrier xcd_barrier_post(unsigned* bar, volatile LAS unsigned* st) {
    XcdBarrier b; b.bar = bar; b.x = xb_xcc_id(); b.st = st;
    if (threadIdx.x == 0) (void)xb_add(&bar[XB_XCNT(b.x)], 1u);
    return b;
}
__device__ __forceinline__ void xcd_barrier_complete(unsigned* bar, unsigned x, unsigned& nloc, unsigned& nx) {
    const unsigned G = gridDim.x * gridDim.y * gridDim.z;
    unsigned sum, cnt, mine, sp = 0u;
    for (;;) {
        sum = 0u; cnt = 0u; mine = 0u;
#pragma unroll
        for (unsigned j = 0; j < 16; ++j) { const unsigned c = xb_ld(&bar[XB_XCNT(j)]); sum += c; cnt += (c > 0u) ? 1u : 0u; mine = (j == x) ? c : mine; }
        if (sum == G) break;
        __builtin_amdgcn_s_sleep(1);
        if ((++sp & 255u) == 0u) { if (xb_ld(&bar[XB_TMO])) break; if (sp > XB_SPIN_CAP) { atomicAdd(&bar[XB_TMO], 1u); break; } }
    }
    nloc = mine > 0u ? mine : 1u; nx = cnt > 0u ? cnt : 1u;
}

__device__ __forceinline__ void xcd_barrier(const XcdBarrier& b) {
    asm volatile("s_waitcnt vmcnt(0)" ::: "memory");
    __syncthreads();
    if (threadIdx.x == 0) {
        unsigned* bar = b.bar;
        __builtin_amdgcn_s_waitcnt(0);
        unsigned nloc = b.st[0], nx = b.st[1];
        if (nloc == 0u) { xcd_barrier_complete(bar, b.x, nloc, nx); b.st[0] = nloc; b.st[1] = nx; }
        const unsigned old = xb_add(&bar[XB_XSUB(b.x)], 1u);
        const unsigned gen = old / nloc;
        if (old + 1u == (gen + 1u) * nloc) {
            __builtin_amdgcn_fence(__ATOMIC_RELEASE, "agent");
            asm volatile("s_waitcnt vmcnt(0)" ::: "memory");
            const unsigned og = xb_add(&bar[XB_TOP], 1u);
            const unsigned tg = og / nx;
            if (og + 1u == (tg + 1u) * nx) xb_add(&bar[XB_TOPGEN], 1u);
            else XB_SPIN(xb_ld(&bar[XB_TOPGEN]) == tg, bar);
            __builtin_amdgcn_fence(__ATOMIC_ACQUIRE, "agent");
            xb_add(&bar[XB_XGEN(b.x)], 1u);
            asm volatile("s_waitcnt vmcnt(0)" ::: "memory");
        } else {
            XB_SPIN(xb_ld(&bar[XB_XGEN(b.x)]) == gen, bar);
            __builtin_amdgcn_fence(__ATOMIC_ACQUIRE, "agent");
            asm volatile("s_waitcnt vmcnt(0)" ::: "memory");
        }
    }
    __syncthreads();
}
namespace att {
typedef short bf16x8 __attribute__((ext_vector_type(8)));
typedef short s16x4 __attribute__((ext_vector_type(4)));
typedef float f32x16 __attribute__((ext_vector_type(16)));
constexpr int NW = 8, QBLK = 32, KVBLK = 64, QB = NW * QBLK;
constexpr int LDS_V = 0, LDS_K = 32768, LDS_WS = 65536, LDS_CS = 65536 + 2048, LDS_END = LDS_CS + 512;
constexpr float THR = 8.f;
#define SBAR() __builtin_amdgcn_sched_barrier(0)
__device__ __forceinline__ int crow(int r, int hi) { return (r & 3) + 8 * (r >> 2) + 4 * hi; }
__device__ __forceinline__ unsigned cvtpk(float lo, float hi) { unsigned r; asm volatile("v_cvt_pk_bf16_f32 %0, %1, %2" : "=v"(r) : "v"(lo), "v"(hi)); return r; }
template <int DH> __device__ __forceinline__ int kswz(int row, int colB) { return row * (DH * 2) + (colB ^ ((row & 7) << 4)); }
template <int DH> __device__ __forceinline__ int v_st(int k, int c) { const int kk = (k & ~0xC) | ((k & 4) << 1) | ((k & 8) >> 1); return ((kk >> 3) * (DH / 32) + (c >> 5)) * 512 + ((kk & 7) * 32 + (c & 31)) * 2; }
__device__ __forceinline__ int v_rd_base(int lane) { return ((lane & 3) << 3) | (((lane >> 2) & 3) << 6) | (((lane >> 4) & 1) << 5) | (((lane >> 5) & 1) << 8); }

__device__ __forceinline__ void mask_tile(f32x16& p0, f32x16& p1, int dq, unsigned W) {
    const float NEG = -__builtin_inff();
#pragma unroll
    for (int r = 0; r < 16; ++r) {
        const int c = (r & 3) + 8 * (r >> 2);
        if ((unsigned)(dq - c) >= W) p0[r] = NEG;
        if ((unsigned)(dq - c - 32) >= W) p1[r] = NEG;
    }
}
template <int DH> __device__ __forceinline__ void partialSM(f32x16& p0, f32x16& p1, float& m_reg, float& mn, float& alpha) {
    constexpr float SCALE = DH == 128 ? 0.08838834764831845f : 0.125f;
    float pmax = p0[0];
#pragma unroll
    for (int r = 1; r < 16; ++r) pmax = fmaxf(pmax, p0[r]);
#pragma unroll
    for (int r = 0; r < 16; ++r) pmax = fmaxf(pmax, p1[r]);
    { auto rr = __builtin_amdgcn_permlane32_swap(__float_as_uint(pmax), __float_as_uint(pmax), false, false);
      pmax = fmaxf(__uint_as_float(rr[0]), __uint_as_float(rr[1])); }
    constexpr float C2 = 1.4426950408889634f * SCALE;
    if (__builtin_expect(__all((pmax - m_reg) * SCALE <= THR), 1)) { mn = m_reg; alpha = 1.f; }
    else { mn = fmaxf(m_reg, pmax); alpha = __builtin_amdgcn_exp2f((m_reg - mn) * C2); m_reg = mn; }
    const float mnL = -mn * C2;
#pragma unroll
    for (int r = 0; r < 16; ++r) p0[r] = fmaf(p0[r], C2, mnL);
#pragma unroll
    for (int r = 0; r < 16; ++r) p1[r] = fmaf(p1[r], C2, mnL);
#pragma unroll
    for (int r = 0; r < 16; ++r) p0[r] = __builtin_amdgcn_exp2f(p0[r]);
}
__device__ __forceinline__ void finishSM(f32x16& p0, f32x16& p1, float alpha, float& l_reg, bf16x8& pa0, bf16x8& pa1, bf16x8& pa2, bf16x8& pa3) {
#pragma unroll
    for (int r = 0; r < 16; ++r) p1[r] = __builtin_amdgcn_exp2f(p1[r]);
    float ps = 0;
#pragma unroll
    for (int r = 0; r < 16; ++r) ps += p0[r];
#pragma unroll
    for (int r = 0; r < 16; ++r) ps += p1[r];
    { auto rr = __builtin_amdgcn_permlane32_swap(__float_as_uint(ps), __float_as_uint(ps), false, false);
      ps = __uint_as_float(rr[0]) + __uint_as_float(rr[1]); }
    l_reg = l_reg * alpha + ps;
#define PK4(P, B_, OUT) do { unsigned a0 = cvtpk(P[B_+0], P[B_+1]), a1 = cvtpk(P[B_+2], P[B_+3]);                          \
        unsigned b0 = cvtpk(P[B_+4], P[B_+5]), b1 = cvtpk(P[B_+6], P[B_+7]);                                             \
        auto r0 = __builtin_amdgcn_permlane32_swap(a0, b0, false, false); auto r1 = __builtin_amdgcn_permlane32_swap(a1, b1, false, false); \
        u32x4 w = {r0[0], r1[0], r0[1], r1[1]}; OUT = *reinterpret_cast<bf16x8*>(&w); } while (0)
    PK4(p0, 0, pa0); PK4(p0, 8, pa1); PK4(p1, 0, pa2); PK4(p1, 8, pa3);
#undef PK4
}
template <int DH, bool FOX, int KB, bool SK>
__device__ __forceinline__ void qkt(f32x16& p0, f32x16& p1, const char* lds, int r32, int hi, const bf16x8* qr, bool act, float ctS) {
    constexpr int SHM_K = KVBLK * DH * 2;
    if (SK && !act) { const float NEG = -__builtin_inff();
#pragma unroll
        for (int r = 0; r < 16; ++r) { p0[r] = NEG; p1[r] = NEG; } return; }
    if constexpr (FOX) {
        const float* cs = (const float*)(lds + LDS_CS + KB * 256) + 4 * hi;
#pragma unroll
        for (int g = 0; g < 4; ++g) { const f32x4 a = *(const f32x4*)(cs + 8 * g), b = *(const f32x4*)(cs + 32 + 8 * g);
#pragma unroll
            for (int e = 0; e < 4; ++e) { p0[4 * g + e] = ctS - a[e]; p1[4 * g + e] = ctS - b[e]; } }
    } else { p0 = f32x16{}; p1 = f32x16{}; }
    const char* K_lds = lds + LDS_K;
    const char* kb[4];
#pragma unroll
    for (int dd = 0; dd < 4; ++dd) kb[dd] = K_lds + KB * SHM_K + kswz<DH>(r32, (dd * 16 + hi * 8) * 2);
#pragma unroll
    for (int d0 = 0; d0 < DH / 16; ++d0) { const char* a = kb[d0 & 3] + (d0 >> 2) * 128;
        bf16x8 b0 = *reinterpret_cast<const bf16x8*>(a);
        bf16x8 b1 = *reinterpret_cast<const bf16x8*>(a + 32 * DH * 2);
        p0 = __builtin_amdgcn_mfma_f32_32x32x16_bf16(b0, qr[d0], p0, 0, 0, 0);
        p1 = __builtin_amdgcn_mfma_f32_32x32x16_bf16(b1, qr[d0], p1, 0, 0, 0); }
}
template <int DH, int VB, bool SK>
__device__ __forceinline__ void pv_tile(f32x16* o, int vb0, bf16x8 pa0, bf16x8 pa1, bf16x8 pa2, bf16x8 pa3, bool act) {
    constexpr int SHM_V = KVBLK * DH * 2, KS = (DH / 32) * 1024, HF = (DH / 32) * 512;
    if (SK && !act) return;
#define TRRD(dst, off) asm volatile("ds_read_b64_tr_b16 %0, %1 offset:%2" : "=&v"(dst) : "v"(vb0), "i"(off) : "memory")
#define PV_D0(d0) do { s16x4 l0, l1, l2, l3, h0, h1, h2, h3; constexpr int b_ = VB * SHM_V + (d0) * 512; \
        TRRD(l0, b_); TRRD(h0, b_ + HF); TRRD(l1, b_ + KS); TRRD(h1, b_ + KS + HF); TRRD(l2, b_ + 2 * KS); TRRD(h2, b_ + 2 * KS + HF); TRRD(l3, b_ + 3 * KS); TRRD(h3, b_ + 3 * KS + HF); \
        asm volatile("s_waitcnt lgkmcnt(0)" ::: "memory"); SBAR();   \
        o[d0] = __builtin_amdgcn_mfma_f32_32x32x16_bf16(pa0, (bf16x8){l0[0], l0[1], l0[2], l0[3], h0[0], h0[1], h0[2], h0[3]}, o[d0], 0, 0, 0);   \
        o[d0] = __builtin_amdgcn_mfma_f32_32x32x16_bf16(pa1, (bf16x8){l1[0], l1[1], l1[2], l1[3], h1[0], h1[1], h1[2], h1[3]}, o[d0], 0, 0, 0);   \
        o[d0] = __builtin_amdgcn_mfma_f32_32x32x16_bf16(pa2, (bf16x8){l2[0], l2[1], l2[2], l2[3], h2[0], h2[1], h2[2], h2[3]}, o[d0], 0, 0, 0);   \
        o[d0] = __builtin_amdgcn_mfma_f32_32x32x16_bf16(pa3, (bf16x8){l3[0], l3[1], l3[2], l3[3], h3[0], h3[1], h3[2], h3[3]}, o[d0], 0, 0, 0); } while (0)
    PV_D0(0); PV_D0(1);
    if constexpr (DH == 128) { PV_D0(2); PV_D0(3); }
#undef PV_D0
#undef TRRD
}

template <int DH, bool FOX>
__device__ __forceinline__ void attn_unit(const bf16_t* Q, const bf16_t* K, const bf16_t* V, const bf16_t* Z, bf16_t* Y, const float* CSb, float sink, int P0, char* lds) {
    constexpr int LDQ = 1024, LDKV = FOX ? 1024 : 128, W = FOX ? (1 << 30) : WIN;
    constexpr bool SK = !FOX;
    constexpr float SCALE = DH == 128 ? 0.08838834764831845f : 0.125f, C2 = 1.4426950408889634f * SCALE;
    constexpr int SHM_K = KVBLK * DH * 2, SHM_V = SHM_K;
    constexpr int TPR = DH / 8, RPP = 512 / TPR, NP = 64 / RPP;
    int tid_ = threadIdx.x; asm volatile("" : "+v"(tid_));
    const int tid = tid_, wid = __builtin_amdgcn_readfirstlane(tid >> 6), lane = tid & 63, r32 = lane & 31, hi = lane >> 5;
    const int lowk = P0 - W + 1, j_lo = lowk > 0 ? lowk / KVBLK : 0, j_hi = (P0 + QB - 1) / KVBLK + 1, NT = j_hi - j_lo;
    const int qlo = P0 + wid * QBLK, qm = qlo + r32 - 4 * hi;
    char* V_lds = lds + LDS_V; char* K_lds = lds + LDS_K;
    float* ws = (float*)(lds + LDS_WS) + wid * 64; float* li_l = ws, * al_l = ws + 32;
    float* cs_l = (float*)(lds + LDS_CS);
    float m_reg = -1e30f, l_reg = 0; f32x16 o[DH / 32];
#pragma unroll
    for (int i = 0; i < DH / 32; ++i) o[i] = f32x16{};
    const int sr = tid / TPR, sc = (tid % TPR) * 8;
    const int vst0 = v_st<DH>(sr, sc), kws0 = kswz<DH>(sr, sc * 2);
    constexpr int VST_STEP = 4 * (DH / 32) * 512, KWS_STEP = 32 * DH * 2;
    const int vb0 = (int)(uintptr_t)V_lds + v_rd_base(lane);
    bf16x8 st_k[NP], st_v[NP]; float st_c = 0.f;
    bf16x8 qr[DH / 16];
    float ctS = 0.f;
    if constexpr (FOX) ctS = CSb[qlo + r32];
#define KBASE(t) ((j_lo + (t)) * KVBLK)
#define ACT(t) (KBASE(t) <= qlo + QBLK - 1 && KBASE(t) + KVBLK - 1 >= qlo - W + 1)
#define MASKT(P0_, P1_, t) do { const int kb_ = KBASE(t); if ((!SK || ACT(t)) && (kb_ + KVBLK - 1 > qlo || kb_ <= qlo + QBLK - 1 - W)) mask_tile(P0_, P1_, qm - kb_, (unsigned)W); } while (0)
#define VMW() asm volatile("s_waitcnt vmcnt(0)" ::: "memory")
#define SLOAD(k0) do { _Pragma("unroll") for (int i_ = 0; i_ < NP; ++i_) { st_v[i_] = *(const bf16x8*)(V + (size_t)((k0) + sr + RPP * i_) * LDKV + sc); st_k[i_] = *(const bf16x8*)(K + (size_t)((k0) + sr + RPP * i_) * LDKV + sc); } \
                       if constexpr (FOX) st_c = CSb[(k0) + lane]; } while (0)
#define SWRITE_K(bf) do { _Pragma("unroll") for (int i_ = 0; i_ < NP; ++i_) *(bf16x8*)(K_lds + (bf) * SHM_K + kws0 + i_ * KWS_STEP) = st_k[i_]; if constexpr (FOX) { if (wid == 0) cs_l[(bf) * 64 + lane] = st_c; } } while (0)
#define SWRITE_V(bf) do { _Pragma("unroll") for (int i_ = 0; i_ < NP; ++i_) *(bf16x8*)(V_lds + (bf) * SHM_V + vst0 + i_ * VST_STEP) = st_v[i_]; } while (0)
#define RESC(a) do { if (__any((a) < 1.f)) { if (hi == 0) al_l[r32] = (a); asm volatile("s_waitcnt lgkmcnt(0)" ::: "memory");              \
                     _Pragma("unroll") for (int d_ = 0; d_ < DH / 32; ++d_) _Pragma("unroll") for (int r = 0; r < 16; ++r) o[d_][r] *= al_l[crow(r, hi)]; } } while (0)
#pragma unroll
    for (int d0 = 0; d0 < DH / 16; ++d0) qr[d0] = *(const bf16x8*)(Q + (size_t)(wid * QBLK + r32) * LDQ + d0 * 16 + hi * 8);
    SLOAD(KBASE(0)); VMW(); SWRITE_K(0); SWRITE_V(0); SBAR();
    if (NT > 1) SLOAD(KBASE(1));
    __syncthreads();
    f32x16 pA0, pA1, pB0, pB1; float mnA, mnB, alA, alB; bf16x8 pa0, pa1, pa2, pa3;
    SBAR(); qkt<DH, FOX, 0, SK>(pA0, pA1, lds, r32, hi, qr, ACT(0), ctS);
    MASKT(pA0, pA1, 0); partialSM<DH>(pA0, pA1, m_reg, mnA, alA);
    if (NT > 1) { VMW(); SWRITE_K(1); SWRITE_V(1); }
    __syncthreads();
#define HALF_STEP(PX0, PX1, mnX, alX, PY0, PY1, alY, t, KB, VB, SB) do {                                                      \
        SBAR(); qkt<DH, FOX, KB, SK>(PX0, PX1, lds, r32, hi, qr, ACT(t), ctS);                                                \
        finishSM(PY0, PY1, alY, l_reg, pa0, pa1, pa2, pa3); SBAR();                                                           \
        if ((t) + 1 < NT) { SLOAD(KBASE((t) + 1)); SBAR(); }                                                                  \
        pv_tile<DH, VB, SK>(o, vb0, pa0, pa1, pa2, pa3, ACT((t) - 1)); MASKT(PX0, PX1, (t)); partialSM<DH>(PX0, PX1, m_reg, mnX, alX); \
        __syncthreads();                                                                                                      \
        if ((t) + 1 < NT) { VMW(); SWRITE_K(SB); SWRITE_V(SB); }                                                              \
        RESC(alX); __syncthreads(); } while (0)
    for (int t = 1; t + 1 < NT; t += 2) {
        HALF_STEP(pB0, pB1, mnB, alB, pA0, pA1, alA, t, 1, 0, 0);
        HALF_STEP(pA0, pA1, mnA, alA, pB0, pB1, alB, t + 1, 0, 1, 1);
    }
    const bool even = (NT & 1) == 0;
    if (even) { SBAR(); qkt<DH, FOX, 1, SK>(pB0, pB1, lds, r32, hi, qr, ACT(NT - 1), ctS); SBAR(); }
    finishSM(pA0, pA1, alA, l_reg, pa0, pa1, pa2, pa3); SBAR();
    pv_tile<DH, 0, SK>(o, vb0, pa0, pa1, pa2, pa3, ACT(even ? NT - 2 : NT - 1));
    if (even) { MASKT(pB0, pB1, NT - 1); partialSM<DH>(pB0, pB1, m_reg, mnB, alB); __syncthreads(); RESC(alB);
        finishSM(pB0, pB1, alB, l_reg, pa0, pa1, pa2, pa3); SBAR(); pv_tile<DH, 1, SK>(o, vb0, pa0, pa1, pa2, pa3, ACT(NT - 1)); }
    SBAR();
    if constexpr (!FOX) l_reg += __builtin_amdgcn_exp2f(sink * 1.4426950408889634f - m_reg * C2);
    if (hi == 0) li_l[r32] = l_reg; asm volatile("s_waitcnt lgkmcnt(0)" ::: "memory");
    float rli[16];
#pragma unroll
    for (int r = 0; r < 16; ++r) rli[r] = __builtin_amdgcn_rcpf(li_l[crow(r, hi)]);
    bf16_t* Yw = Y + (size_t)(wid * QBLK) * LDQ; const bf16_t* Zw = Z + (size_t)(wid * QBLK) * LDQ;
#pragma unroll
    for (int r = 0; r < 16; ++r) { const int orow = crow(r, hi);
#pragma unroll
        for (int d0 = 0; d0 < DH / 32; ++d0) { const float v = o[d0][r] * rli[r];
            const float vn = __shfl_xor(v, 1);
            if ((r32 & 1) == 0) { const unsigned zz = *(const unsigned*)(Zw + (size_t)orow * LDQ + d0 * 32 + r32);
                *(unsigned*)(Yw + (size_t)orow * LDQ + d0 * 32 + r32) = cvtpk(v * __uint_as_float(zz << 16), vn * __uint_as_float(zz & 0xffff0000u)); } } }
    __syncthreads();
#undef KBASE
#undef ACT
#undef MASKT
#undef VMW
#undef SLOAD
#undef SWRITE_K
#undef SWRITE_V
#undef RESC
#undef HALF_STEP
}
#undef SBAR
}

#define MK_PHASE2 { \
    unsigned* qctr = ctl + 2048; constexpr int NFOX = BATCH * FH * (SEQ / 256), NSWA = BATCH * SQH * (SEQ / 256); \
    for (;;) { \
        if (tid == 0) MISC[16] = __hip_atomic_fetch_add(qctr, 1u, __ATOMIC_RELAXED, __HIP_MEMORY_SCOPE_AGENT); \
        __syncthreads(); const int it = (int)MISC[16]; __syncthreads(); \
        if (it >= NFOX + NSWA) break; \
        if (it < NFOX) { const int qb = 15 - it / 16, bh = it % 16, b = bh / FH, h = bh % FH; const size_t ro = ((size_t)b * SEQ + qb * 256) * 1024 + h * FD; \
            att::attn_unit<FD, true>(QA + ro, KA + (size_t)b * SEQ * 1024 + h * FD, VA + (size_t)b * SEQ * 1024 + h * FD, ZA + ro, YA + ro, CS + (size_t)bh * SEQ, 0.f, qb * 256, (char*)lds_raw); } \
        else { const int j = it - NFOX, qb = j % 16, bh = j / 16, b = bh / SQH, h = bh % SQH; const size_t ro = ((size_t)b * SEQ + qb * 256) * 1024 + h * SD; \
            att::attn_unit<SD, false>(QB + ro, KB + (size_t)b * SEQ * 128 + (h / 8) * SD, VB + (size_t)b * SEQ * 128 + (h / 8) * SD, ZB + ro, YB + ro, nullptr, a.sinks[h], qb * 256, (char*)lds_raw); } \
    } }
#ifndef MK_CT
#define MK_CT MK_MASK
#endif
constexpr int RING_OFF = 0, RING_BYTES = 131072;
constexpr int LDSCTL_OFF = RING_BYTES, MISC_OFF = LDSCTL_OFF + 320;
constexpr int LDS_BYTES = 147456;
constexpr int CW_BAR = 4096;
constexpr size_t CTL_ZERO_BYTES = 1 * MiB;
constexpr int N_PHASES = 7;

struct Args { const float* x; const float* p; const int* pos; const float* pre_g; const float* w_in; const float* b_f; const float* sinks; const float* w_of; const float* w_os;
              const float* w_out; const float* post_g; const float* w_ple; const float* w_pg; float* out; unsigned char* ws; int ph_lo, ph_hi, li, pad; };

__device__ __forceinline__ void p0_transpose_item(const float* W, int ldw, int K, bf16_t* WT, int drow0, int nsrc, int pdst, int k0, LAS float* scr, int lane) {
#pragma unroll 8
    for (int i = 0; i < 32; ++i) { const int kk = 2 * i + (lane >> 5); scr[kk * 33 + pdst] = W[(size_t)(k0 + kk) * ldw + nsrc]; }
    LDS_WAIT(); asm volatile("" ::: "memory");
    const int c = lane & 7;
#pragma unroll
    for (int j = 0; j < 4; ++j) { const int n = (lane >> 3) + 8 * j; const LAS float* s = scr + (8 * c) * 33 + n;
        u32x4 o; o.x = pk2(s[0 * 33], s[1 * 33]); o.y = pk2(s[2 * 33], s[3 * 33]); o.z = pk2(s[4 * 33], s[5 * 33]); o.w = pk2(s[6 * 33], s[7 * 33]);
        *(u32x4*)(WT + (size_t)(drow0 + n) * K + k0 + 8 * c) = o; }
    LDS_WAIT(); asm volatile("" ::: "memory");
}

__global__ void __launch_bounds__(NWAVES * 64, 2) mk_fwd(Args a) {
    extern __shared__ __attribute__((aligned(16))) unsigned char lds_raw[];
    LAS unsigned char* lds = (LAS unsigned char*)lds_raw;
    volatile LAS unsigned* MISC = (volatile LAS unsigned*)(lds + MISC_OFF);
    const int tid = threadIdx.x, lane = tid & 63, wave = __builtin_amdgcn_readfirstlane(tid >> 6);
    const int G = gridDim.x, bx = blockIdx.x;
    const int vcu = (G % 8 == 0) ? (bx % 8) * (G / 8) + bx / 8 : bx;
    unsigned char* ws = a.ws;
    unsigned* ctl = (unsigned*)(ws + WS_CTL);
    bf16_t* XN = (bf16_t*)(ws + WS_XN); float* CS = (float*)(ws + WS_CS); float* LF = (float*)(ws + WS_LF); float* COS = (float*)(ws + WS_COS); float* SIN = (float*)(ws + WS_SIN);
    bf16_t* PB = (bf16_t*)(ws + WS_PB); bf16_t* QA = (bf16_t*)(ws + WS_QA); bf16_t* KA = (bf16_t*)(ws + WS_KA); bf16_t* VA = (bf16_t*)(ws + WS_VA); bf16_t* ZA = (bf16_t*)(ws + WS_ZA);
    bf16_t* QB = (bf16_t*)(ws + WS_QB); bf16_t* KB = (bf16_t*)(ws + WS_KB); bf16_t* VB = (bf16_t*)(ws + WS_VB); bf16_t* ZB = (bf16_t*)(ws + WS_ZB);
    bf16_t* GA = (bf16_t*)(ws + WS_GA); bf16_t* GB = (bf16_t*)(ws + WS_GB); bf16_t* EB = (bf16_t*)(ws + WS_E); bf16_t* YA = (bf16_t*)(ws + WS_YA); bf16_t* YB = (bf16_t*)(ws + WS_YB);
    bf16_t* MERGED = (bf16_t*)(ws + WS_XN); float* OUTP = (float*)(ws + WS_OUTP); bf16_t* XN2 = (bf16_t*)(ws + WS_XN);
    bf16_t* WtIn = (bf16_t*)(ws + WS_WIN); bf16_t* WtOf = (bf16_t*)(ws + WS_WOF); bf16_t* WtOs = (bf16_t*)(ws + WS_WOS); bf16_t* WtOut = (bf16_t*)(ws + WS_WOUT);
    bf16_t* WtG = (bf16_t*)(ws + WS_WG); bf16_t* WtPle = (bf16_t*)(ws + WS_WPLE);

    for (int u = tid; u < (LDS_BYTES - LDSCTL_OFF) / 4; u += NWAVES * 64) ((LAS unsigned*)(lds + LDSCTL_OFF))[u] = 0u;
    __syncthreads();
    XcdBarrier bar = xcd_barrier_post(ctl + CW_BAR + a.li * XCD_BAR_WORDS, MISC + 8);
    const int lo = a.ph_lo, hi = a.ph_hi;
#define IN(k) (((MK_CT >> (k)) & 1) && lo <= (k) && (k) < hi)
#define SEAM(k) do { if (IN(k) && IN((k) + 1)) xcd_barrier(bar); } while (0)

    if (IN(0)) {
        LAS float* scr = (LAS float*)(lds + RING_OFF + wave * 16384);
        const int gw = vcu * NWAVES + wave, NGW = G * NWAVES;
        constexpr int I_IN = 32 * 328, I_O = 16 * 64, I_SQ = 32 * 64, I_PLE = 4 * 64;
        constexpr int NITEMS = I_IN + 2 * I_O + 2 * I_SQ + I_PLE;
        const int l5 = lane & 31;
        for (int it = gw; it < NITEMS; it += NGW) {
            int r = it;
            if (r < I_IN) { const int kb = r / 328, nb = r % 328, n0 = 32 * nb; int nsrc, pdst;
                if (n0 < 4096) { nsrc = n0 + l5; pdst = l5; }
                else if (n0 < 5248) { const int hb = (n0 >> 5) & 1, half = l5 >> 4, s = l5 & 15; nsrc = (n0 & ~63) + 8 + 16 * hb + s + 32 * half; pdst = 8 * (s >> 2) + 4 * half + (s & 3); }
                else { nsrc = n0 + 8 + l5; pdst = l5; }
                p0_transpose_item(a.w_in, NIN, DM, WtIn, n0, nsrc, pdst, 64 * kb, scr, lane); continue; }
            r -= I_IN;
            if (r < I_O) { const int kb = r / 64, nb = r % 64; p0_transpose_item(a.w_of, DM, 1024, WtOf, 32 * nb, 32 * nb + l5, l5, 64 * kb, scr, lane); continue; }
            r -= I_O;
            if (r < I_O) { const int kb = r / 64, nb = r % 64; p0_transpose_item(a.w_os, DM, 1024, WtOs, 32 * nb, 32 * nb + l5, l5, 64 * kb, scr, lane); continue; }
            r -= I_O;
            if (r < I_SQ) { const int kb = r / 64, nb = r % 64; p0_transpose_item(a.w_out, DM, DM, WtOut, 32 * nb, 32 * nb + l5, l5, 64 * kb, scr, lane); continue; }
            r -= I_SQ;
            if (r < I_SQ) { const int kb = r / 64, nb = r % 64; p0_transpose_item(a.w_pg, DM, DM, WtG, 32 * nb, 32 * nb + l5, l5, 64 * kb, scr, lane); continue; }
            r -= I_SQ;
            { const int kb = r / 64, nb = r % 64; p0_transpose_item(a.w_ple, DM, PLE, WtPle, 32 * nb, 32 * nb + l5, l5, 64 * kb, scr, lane); }
        }
        __syncthreads();
        LAS float* wf = (LAS float*)(lds + RING_OFF);
        for (int k = tid; k < DM; k += NWAVES * 64) { const f32x4 w0 = *(const f32x4*)(a.w_in + (size_t)k * NIN + C_F), w1 = *(const f32x4*)(a.w_in + (size_t)k * NIN + C_F + 4);
            wf[0 * DM + k] = w0.x; wf[1 * DM + k] = w0.y; wf[2 * DM + k] = w0.z; wf[3 * DM + k] = w0.w; wf[4 * DM + k] = w1.x; wf[5 * DM + k] = w1.y; wf[6 * DM + k] = w1.z; wf[7 * DM + k] = w1.w; }
        __syncthreads();
        for (int m = gw; m < T; m += NGW) {
            const f32x4* xr = (const f32x4*)(a.x + (size_t)m * DM) + lane;
            f32x4 v[8]; float ss = 0.f;
#pragma unroll
            for (int j = 0; j < 8; ++j) { v[j] = xr[64 * j]; ss += (v[j].x * v[j].x + v[j].y * v[j].y) + (v[j].z * v[j].z + v[j].w * v[j].w); }
            ss = wave_sum(ss);
            const float rstd = 1.0f / sqrtf(ss * (1.0f / DM) + EPS);
            float fa[8];
#pragma unroll
            for (int h = 0; h < 8; ++h) fa[h] = 0.f;
#pragma unroll
            for (int j = 0; j < 8; ++j) {
                const f32x4 gg = ((const f32x4*)a.pre_g)[lane + 64 * j];
                const f32x4 hv = v[j] * rstd * gg;
                u32x2 o; o.x = pk2(hv.x, hv.y); o.y = pk2(hv.z, hv.w);
                *((u32x2*)(XN + (size_t)m * DM) + lane + 64 * j) = o;
#pragma unroll
                for (int h = 0; h < 8; ++h) { const f32x4 w = *(const LAS f32x4*)(wf + h * DM + 256 * j + 4 * lane); fa[h] += (hv.x * w.x + hv.y * w.y) + (hv.z * w.z + hv.w * w.w); }
                asm volatile("" ::: "memory");
            }
            const int b = m / SEQ, s = m % SEQ;
            float mine = 0.f;
#pragma unroll
            for (int h = 0; h < 8; ++h) { const float f = wave_sum(fa[h]); if (lane == h) mine = f; }
            if (lane < 8) { const float z = mine + a.b_f[lane]; LF[((size_t)b * FH + lane) * SEQ + s] = fminf(z, 0.f) - log1pf(__expf(-fabsf(z))); }
            if (lane < 32) { double rev = (double)a.pos[m] * INVF_REV[lane]; rev -= floor(rev); float c, sn; sincos_rev(rev, c, sn); COS[(size_t)m * 32 + lane] = c; SIN[(size_t)m * 32 + lane] = sn; }
            { const f32x4 pv = ((const f32x4*)(a.p + (size_t)m * PLE))[lane]; u32x2 o; o.x = pk2(pv.x, pv.y); o.y = pk2(pv.z, pv.w); *((u32x2*)(PB + (size_t)m * PLE) + lane) = o; }
        }
        __syncthreads();
    }
    SEAM(0);

    if (IN(1)) {
        if (bx < BATCH * FH) {
            LAS double* part = (LAS double*)(lds + RING_OFF);
            const float* src = LF + (size_t)bx * SEQ + tid * 8;
            double loc[8]; double run = 0.0;
#pragma unroll
            for (int i = 0; i < 8; ++i) { run += (double)src[i]; loc[i] = run; }
            part[tid] = run; __syncthreads();
            for (int o = 1; o < 512; o <<= 1) { const double t = tid >= o ? part[tid - o] : 0.0; __syncthreads(); part[tid] += t; __syncthreads(); }
            const double base = tid ? part[tid - 1] : 0.0;
#pragma unroll
            for (int i = 0; i < 8; ++i) CS[(size_t)bx * SEQ + tid * 8 + i] = (float)((base + loc[i]) * 11.313708498984761);
            __syncthreads();
        }
#ifndef P1_NOPROJ
        { pg8::Gemm g{XN, WtIn, T, 10496, DM}; pg8::StaticOrder S; S.init(T, 10496, G, bx);
          pg8::EpiProj E{ws};
          pg8::gemm_phase<pg8::EpiProj, pg8::StaticOrder, true, true>(lds + RING_OFF, g, S, E); }
#endif
#ifndef P1_NOE
        { int kple = PLE; asm volatile("" : "+s"(kple)); pg8::Gemm g{PB, WtPle, T, DM, kple}; pg8::StaticOrder S; S.init(T, DM, G, bx);
          pg8::EpiCopy E{EB, DM};
          pg8::gemm_phase<pg8::EpiCopy, pg8::StaticOrder, true, true>(lds + RING_OFF, g, S, E); }
#endif
    }
    SEAM(1);

    if (IN(2)) {
        MK_PHASE2
    }
    SEAM(2);

    if (IN(3)) {
        { pg8::Gemm g{YA, WtOf, T, DM, 1024}; pg8::StaticOrder S; S.init(T, DM, G, bx); pg8::EpiGate<0> E{MERGED, GA};
          pg8::gemm_phase<pg8::EpiGate<0>, pg8::StaticOrder, true, true>(lds + RING_OFF, g, S, E); }
        VM_WAIT();
        { pg8::Gemm g{YB, WtOs, T, DM, 1024}; pg8::StaticOrder S; S.init(T, DM, G, bx); pg8::EpiGate<1> E{MERGED, GB};
          pg8::gemm_phase<pg8::EpiGate<1>, pg8::StaticOrder, true, true>(lds + RING_OFF, g, S, E); }
    }
    SEAM(3);

    if (IN(4)) {
        pg8::Gemm g{MERGED, WtOut, T, DM, DM}; pg8::StaticOrder S; S.init(T, DM, G, bx); pg8::EpiF32 E{OUTP};
        pg8::gemm_phase<pg8::EpiF32, pg8::StaticOrder, true, true>(lds + RING_OFF, g, S, E);
    }
    SEAM(4);

    if (IN(5)) {
        const int gw = vcu * NWAVES + wave, NGW = G * NWAVES;
        for (int m = gw; m < T; m += NGW) {
            const f32x4* orow = (const f32x4*)(OUTP + (size_t)m * DM) + lane; const f32x4* xr = (const f32x4*)(a.x + (size_t)m * DM) + lane;
            f32x4 v[8]; float ss = 0.f;
#pragma unroll
            for (int j = 0; j < 8; ++j) { v[j] = orow[64 * j]; ss += (v[j].x * v[j].x + v[j].y * v[j].y) + (v[j].z * v[j].z + v[j].w * v[j].w); }
            ss = wave_sum(ss);
            const float rstd = 1.0f / sqrtf(ss * (1.0f / DM) + EPS);
#pragma unroll
            for (int j = 0; j < 8; ++j) { const f32x4 gg = ((const f32x4*)a.post_g)[lane + 64 * j]; const f32x4 r = xr[64 * j] + v[j] * rstd * gg;
                ((f32x4*)(a.out + (size_t)m * DM))[lane + 64 * j] = r; u32x2 o; o.x = pk2(r.x, r.y); o.y = pk2(r.z, r.w); *((u32x2*)(XN2 + (size_t)m * DM) + lane + 64 * j) = o; }
        }
    }
    SEAM(5);

    if (IN(6)) {
        pg8::Gemm g{XN2, WtG, T, DM, DM}; pg8::StaticOrder S; S.init(T, DM, G, bx); pg8::EpiFinal E{a.out, EB};
        pg8::gemm_phase<pg8::EpiFinal, pg8::StaticOrder, true, true>(lds + RING_OFF, g, S, E);
    }
#undef IN
#undef SEAM
}

static void nv_launch_gemm(hipStream_t st, const bf16_t* A, int lda, const float* B, int ldb, int bcol0, int M, int N, int K, int epi, void* O, int ldo, const void* a0, const void* a1) {
    NvGemm g{}; g.A = A; g.lda = lda; g.B = B; g.ldb = ldb; g.bcol0 = bcol0; g.M = M; g.N = N; g.K = K; g.epi = epi; g.O = O; g.ldo = ldo; g.aux0 = a0; g.aux1 = a1;
    nv_gemm<<<dim3(N / 64, M / 64), 256, 0, st>>>(g);
}

#ifndef MK_MASK
#define MK_MASK 0x03
#endif

extern "C" void kernel_launch(void* const* d_in, const int* in_sizes, int n_in, void* d_out, int out_size, void* d_ws, size_t ws_size, hipStream_t stream) {
    static int grid = 0;
    if (grid == 0) {
        if (n_in != 13 || in_sizes[0] != T * DM || out_size != T * DM || ws_size < WS_END) { fprintf(stderr, "kernel_launch: unexpected shapes (n_in %d, in0 %d, out %d, ws %zu)\n", n_in, n_in > 0 ? in_sizes[0] : -1, out_size, ws_size); grid = -1; return; }
        int dev = 0, cus = 0, per_cu = 0;
        if (hipGetDevice(&dev) != hipSuccess || hipDeviceGetAttribute(&cus, hipDeviceAttributeMultiprocessorCount, dev) != hipSuccess) { fprintf(stderr, "kernel_launch: device query failed\n"); grid = -1; return; }
        if (hipFuncSetAttribute((const void*)mk_fwd, hipFuncAttributeMaxDynamicSharedMemorySize, LDS_BYTES) != hipSuccess) { fprintf(stderr, "kernel_launch: hipFuncSetAttribute failed\n"); grid = -1; return; }
        if (hipOccupancyMaxActiveBlocksPerMultiprocessor(&per_cu, (const void*)mk_fwd, NWAVES * 64, LDS_BYTES) != hipSuccess || per_cu < 1) fprintf(stderr, "kernel_launch: note: occupancy query reports %d workgroups per CU\n", per_cu);
        (void)hipGetLastError();
        grid = cus;
        if (grid != 256) fprintf(stderr, "kernel_launch: note: %d CUs (tuned for 256)\n", grid);
    }
    if (grid < 0) return;
    const float* x = (const float*)d_in[0]; const float* p = (const float*)d_in[1]; const int* pos = (const int*)d_in[2]; const float* pre_g = (const float*)d_in[3];
    const float* w_in = (const float*)d_in[4]; const float* b_f = (const float*)d_in[5]; const float* sinks = (const float*)d_in[6]; const float* w_of = (const float*)d_in[7];
    const float* w_os = (const float*)d_in[8]; const float* w_out = (const float*)d_in[9]; const float* post_g = (const float*)d_in[10]; const float* w_ple = (const float*)d_in[11]; const float* w_pg = (const float*)d_in[12];
    char* ws = (char*)d_ws; float* out = (float*)d_out;
    bf16_t* XN = (bf16_t*)(ws + WS_XN); float* CS = (float*)(ws + WS_CS); float* LF = (float*)(ws + WS_LF); float* COS = (float*)(ws + WS_COS); float* SIN = (float*)(ws + WS_SIN);
    bf16_t* PB = (bf16_t*)(ws + WS_PB); bf16_t* QA = (bf16_t*)(ws + WS_QA); bf16_t* KA = (bf16_t*)(ws + WS_KA); bf16_t* VA = (bf16_t*)(ws + WS_VA); bf16_t* ZA = (bf16_t*)(ws + WS_ZA);
    bf16_t* QB = (bf16_t*)(ws + WS_QB); bf16_t* KB = (bf16_t*)(ws + WS_KB); bf16_t* VB = (bf16_t*)(ws + WS_VB); bf16_t* ZB = (bf16_t*)(ws + WS_ZB);
    bf16_t* GA = (bf16_t*)(ws + WS_GA); bf16_t* GB = (bf16_t*)(ws + WS_GB); bf16_t* E = (bf16_t*)(ws + WS_E); bf16_t* YA = (bf16_t*)(ws + WS_YA); bf16_t* YB = (bf16_t*)(ws + WS_YB);
    bf16_t* MERGED = (bf16_t*)(ws + WS_XN); float* OUTP = (float*)(ws + WS_OUTP); bf16_t* XN2 = (bf16_t*)(ws + WS_XN);

    if (hipMemsetAsync(ws + WS_CTL, 0, CTL_ZERO_BYTES, stream) != hipSuccess) { fprintf(stderr, "kernel_launch: hipMemsetAsync failed\n"); return; }
    Args a{};
    a.x = x; a.p = p; a.pos = pos; a.pre_g = pre_g; a.w_in = w_in; a.b_f = b_f; a.sinks = sinks; a.w_of = w_of; a.w_os = w_os; a.w_out = w_out; a.post_g = post_g; a.w_ple = w_ple; a.w_pg = w_pg;
    a.out = out; a.ws = (unsigned char*)d_ws;
    int li = 0;
    for (int ph = 0; ph < N_PHASES;) {
        if ((MK_MASK >> ph) & 1) {
            int e = ph; while (e < N_PHASES && ((MK_MASK >> e) & 1)) ++e;
            a.ph_lo = ph; a.ph_hi = e; a.li = li++;
            hipLaunchKernelGGL(mk_fwd, dim3(grid), dim3(NWAVES * 64), LDS_BYTES, stream, a);
            const hipError_t le = hipPeekAtLastError();
            if (le != hipSuccess) { fprintf(stderr, "kernel_launch: launch failed: %s\n", hipGetErrorName(le)); return; }
            ph = e; continue;
        }
        switch (ph) {
            case 0: nv_prep<<<1024, 256, 0, stream>>>(x, p, pos, pre_g, w_in, b_f, XN, LF, COS, SIN, PB); break;
            case 1:
                nv_cumsum<<<BATCH * FH, 256, 0, stream>>>(LF, CS);
                nv_launch_gemm(stream, XN, DM, w_in, NIN, C_QA, T, 1024, DM, EPI_COPY, QA, 1024, nullptr, nullptr);
                nv_launch_gemm(stream, XN, DM, w_in, NIN, C_KA, T, 1024, DM, EPI_COPY, KA, 1024, nullptr, nullptr);
                nv_launch_gemm(stream, XN, DM, w_in, NIN, C_VA, T, 1024, DM, EPI_COPY, VA, 1024, nullptr, nullptr);
                nv_launch_gemm(stream, XN, DM, w_in, NIN, C_ZA, T, 1024, DM, EPI_SILU, ZA, 1024, nullptr, nullptr);
                nv_launch_gemm(stream, XN, DM, w_in, NIN, C_QB, T, 1024, DM, EPI_ROPE, QB, 1024, COS, SIN);
                nv_launch_gemm(stream, XN, DM, w_in, NIN, C_KB, T, 128, DM, EPI_ROPE, KB, 128, COS, SIN);
                nv_launch_gemm(stream, XN, DM, w_in, NIN, C_VB, T, 128, DM, EPI_COPY, VB, 128, nullptr, nullptr);
                nv_launch_gemm(stream, XN, DM, w_in, NIN, C_ZB, T, 1024, DM, EPI_SILU, ZB, 1024, nullptr, nullptr);
                nv_launch_gemm(stream, XN, DM, w_in, NIN, C_GA, T, 2048, DM, EPI_SIGM, GA, 2048, nullptr, nullptr);
                nv_launch_gemm(stream, XN, DM, w_in, NIN, C_GB, T, 2048, DM, EPI_SIGM, GB, 2048, nullptr, nullptr);
                nv_launch_gemm(stream, PB, PLE, w_ple, DM, 0, T, DM, PLE, EPI_COPY, E, DM, nullptr, nullptr);
                break;
            case 2:
                nv_attn<FD, true><<<BATCH * FH * SEQ / 4, 256, 0, stream>>>(QA, KA, VA, 1024, CS, nullptr, ZA, YA);
                nv_attn<SD, false><<<BATCH * SQH * SEQ / 4, 256, 0, stream>>>(QB, KB, VB, 128, nullptr, sinks, ZB, YB);
                break;
            case 3:
                nv_launch_gemm(stream, YA, 1024, w_of, DM, 0, T, DM, 1024, EPI_GATE1, MERGED, DM, GA, nullptr);
                nv_launch_gemm(stream, YB, 1024, w_os, DM, 0, T, DM, 1024, EPI_GATE2, MERGED, DM, GB, nullptr);
                break;
            case 4: nv_launch_gemm(stream, MERGED, DM, w_out, DM, 0, T, DM, DM, EPI_F32, OUTP, DM, nullptr, nullptr); break;
            case 5: nv_post<<<1024, 256, 0, stream>>>(x, OUTP, post_g, out, XN2); break;
            default: nv_launch_gemm(stream, XN2, DM, w_pg, DM, 0, T, DM, DM, EPI_FINAL, out, DM, E, nullptr); break;
        }
        ++ph;
    }
}
```
